# Optimizing an MI355X kernel written in HIP

```python
import math
import jax, jax.numpy as jnp
from jax import lax
import numpy as np

D_MODEL = 2048
BATCH = 2
SEQ = 4096
DEPTH = 1

N_META = 16
GDN_HEADS = 16
GDN_DK = 128
GDN_DV = 128
CONV_K = 4
CHUNK = 64
FOX_HEADS = 16
FOX_DH = 128
Q_BLOCK = 128
D_FF = 4 * D_MODEL
NORM_EPS = 1e-6

GDN_QK = GDN_HEADS * GDN_DK
GDN_V = GDN_HEADS * GDN_DV
GDN_CONV_DIM = 2 * GDN_QK + GDN_V
FOX_W = FOX_HEADS * FOX_DH
IN_SPLITS = (GDN_CONV_DIM, GDN_V, GDN_HEADS, GDN_HEADS, 3 * FOX_W, FOX_HEADS, D_MODEL, D_MODEL)
N_IN = sum(IN_SPLITS)
IN_SPLIT_IDX = tuple(int(i) for i in np.cumsum(IN_SPLITS)[:-1])

kernel_name = "gdn_fox_gated_hybrid_block"


def rms_norm(x, g):
    xf = x.astype(jnp.float32)
    y = xf * lax.rsqrt(jnp.mean(jnp.square(xf), axis=-1, keepdims=True) + NORM_EPS)
    return (y * g.astype(jnp.float32)).astype(x.dtype)


def l2_normalize(x):
    return x * lax.rsqrt(jnp.sum(jnp.square(x), axis=-1, keepdims=True) + NORM_EPS)


def causal_depthwise_conv(x, w):
    L = x.shape[1]
    xp = jnp.pad(x, ((0, 0), (CONV_K - 1, 0), (0, 0)))
    return sum(xp[:, k:k + L] * w[k] for k in range(CONV_K))


def chunked_gated_delta_rule(q, k, v, g, beta):
    B, H, L, DK = q.shape
    DV = v.shape[-1]
    N = L // CHUNK
    rs = lambda t: t.reshape(B, H, N, CHUNK, *t.shape[3:])
    q, k, v, g, beta = rs(q) * DK ** -0.5, rs(k), rs(v), rs(g), rs(beta)
    g = jnp.cumsum(g, axis=-1)
    causal = jnp.tril(jnp.ones((CHUNK, CHUNK), bool))
    strict = jnp.tril(jnp.ones((CHUNK, CHUNK), bool), -1)
    decay = jnp.exp(jnp.where(causal, g[..., :, None] - g[..., None, :], -jnp.inf))
    k_beta = k * beta[..., None]
    a_mat = jnp.where(strict, jnp.einsum('bhncd,bhnsd->bhncs', k_beta, k) * decay, 0.0)
    eye = jnp.eye(CHUNK, dtype=q.dtype)
    rhs = jnp.concatenate([v * beta[..., None], k_beta * jnp.exp(g)[..., None]], axis=-1)
    sol = lax.linalg.triangular_solve(a_mat + eye, rhs, left_side=True, lower=True, unit_diagonal=True)
    w_val, w_key = sol[..., :DV], sol[..., DV:]
    qk_intra = jnp.where(causal, jnp.einsum('bhncd,bhnsd->bhncs', q, k) * decay, 0.0)
    q_dec = q * jnp.exp(g)[..., None]
    k_dec = k * jnp.exp(g[..., -1:] - g)[..., None]
    g_last = jnp.exp(g[..., -1])

    def step(S, inp):
        qk_c, q_dec_c, k_dec_c, w_val_c, w_key_c, g_last_c = inp
        v_new = w_val_c - jnp.einsum('bhck,bhkv->bhcv', w_key_c, S)
        o = jnp.einsum('bhck,bhkv->bhcv', q_dec_c, S) + jnp.einsum('bhcs,bhsv->bhcv', qk_c, v_new)
        S = S * g_last_c[..., None, None] + jnp.einsum('bhck,bhcv->bhkv', k_dec_c, v_new)
        return S, o

    xs = tuple(jnp.moveaxis(t, 2, 0) for t in (qk_intra, q_dec, k_dec, w_val, w_key, g_last))
    S0 = jnp.zeros((B, H, DK, DV), q.dtype)
    _, o = lax.scan(step, S0, xs)
    return jnp.moveaxis(o, 0, 2).reshape(B, H, L, DV)


def gated_deltanet_branch(qkv, z, b, a, conv_w, a_log, dt_bias, norm_g):
    B, L, _ = qkv.shape
    out_dtype = qkv.dtype
    f32 = jnp.float32
    pad = (-L) % CHUNK
    Lp = L + pad
    front = lambda t: jnp.pad(t, ((0, 0), (pad, 0)) + ((0, 0),) * (t.ndim - 2))
    qkv = jax.nn.silu(causal_depthwise_conv(front(qkv.astype(f32)), conv_w.astype(f32)))
    q, k, v = jnp.split(qkv, [GDN_QK, 2 * GDN_QK], axis=-1)
    q = l2_normalize(q.reshape(B, Lp, GDN_HEADS, GDN_DK))
    k = l2_normalize(k.reshape(B, Lp, GDN_HEADS, GDN_DK))
    v = v.reshape(B, Lp, GDN_HEADS, GDN_DV)
    beta = front(jax.nn.sigmoid(b.astype(f32)))
    g = front(-jnp.exp(a_log.astype(f32)) * jax.nn.softplus(a.astype(f32) + dt_bias.astype(f32)))
    bhl = lambda t: jnp.moveaxis(t, 2, 1)
    o = chunked_gated_delta_rule(bhl(q), bhl(k), bhl(v), bhl(g), bhl(beta))
    o = jnp.moveaxis(o, 1, 2)[:, pad:]
    o = rms_norm(o, norm_g) * jax.nn.silu(z.astype(f32).reshape(B, L, GDN_HEADS, GDN_DV))
    return o.reshape(B, L, GDN_V).astype(out_dtype)


def fox_branch(qkv, f_logit, q_norm_g, k_norm_g, f_bias):
    B, L, _ = qkv.shape
    pad = (-L) % Q_BLOCK
    Lp = L + pad
    nblk = Lp // Q_BLOCK
    q, k, v = jnp.split(qkv, 3, axis=-1)
    heads = lambda t: jnp.pad(t, ((0, 0), (0, pad), (0, 0), (0, 0))).transpose(0, 2, 1, 3)
    q = heads(rms_norm(q.reshape(B, L, FOX_HEADS, FOX_DH), q_norm_g))
    k = heads(rms_norm(k.reshape(B, L, FOX_HEADS, FOX_DH), k_norm_g))
    v = heads(v.reshape(B, L, FOX_HEADS, FOX_DH))
    log_f = jax.nn.log_sigmoid(f_logit.astype(jnp.float32) + f_bias.astype(jnp.float32))
    c = jnp.cumsum(log_f, axis=1)
    c = jnp.pad(c, ((0, 0), (0, pad), (0, 0)), mode='edge').transpose(0, 2, 1)
    kpos = jnp.arange(Lp)
    scale = FOX_DH ** -0.5

    def block(i):
        start = i * Q_BLOCK
        qs = lax.dynamic_slice_in_dim(q, start, Q_BLOCK, axis=2)
        cq = lax.dynamic_slice_in_dim(c, start, Q_BLOCK, axis=2)
        s = jnp.einsum('bhqd,bhkd->bhqk', qs, k).astype(jnp.float32) * scale
        s = s + cq[..., :, None] - c[..., None, :]
        qpos = start + jnp.arange(Q_BLOCK)
        s = jnp.where(kpos[None, :] <= qpos[:, None], s, -jnp.inf)
        p = jax.nn.softmax(s, axis=-1).astype(v.dtype)
        return jnp.einsum('bhqk,bhkd->bhqd', p, v)

    o = lax.map(block, jnp.arange(nblk))
    o = jnp.transpose(o, (1, 0, 3, 2, 4)).reshape(B, Lp, FOX_W)
    return o[:, :L]


def hybrid_layer(h, mix_norm_g, w_in, conv_w, a_log, dt_bias, gdn_norm_g, w_o_gdn,
                 fox_q_norm_g, fox_k_norm_g, fox_f_bias, w_o_fox, w_out, mlp_norm_g, w_up, w_down):
    u = rms_norm(h, mix_norm_g)
    p = u @ w_in
    qkv_a, z_a, b_a, a_a, qkv_b, f_b, gate_a, gate_b = jnp.split(p, IN_SPLIT_IDX, axis=-1)
    y_a = gated_deltanet_branch(qkv_a, z_a, b_a, a_a, conv_w, a_log, dt_bias, gdn_norm_g)
    y_b = fox_branch(qkv_b, f_b, fox_q_norm_g, fox_k_norm_g, fox_f_bias)
    mix = jax.nn.sigmoid(gate_a) * (y_a @ w_o_gdn) + jax.nn.sigmoid(gate_b) * (y_b @ w_o_fox)
    h = h + mix @ w_out
    u = rms_norm(h, mlp_norm_g)
    h = h + jnp.square(jax.nn.relu(u @ w_up)) @ w_down
    return h


def setup_inputs(seed: int = 0) -> dict:
    key = jax.random.key(seed)
    ks = jax.random.split(key, 20)
    f32 = jnp.float32
    nrm = lambda k, shape, scale: jax.random.normal(k, shape, f32) * scale
    gain = lambda k, shape: 1.0 + 0.02 * jax.random.normal(k, shape, f32)
    x = nrm(ks[0], (BATCH, SEQ, D_MODEL), 1.0)
    meta_tokens = nrm(ks[1], (N_META, D_MODEL), 1.0)
    mix_norm_g = gain(ks[2], (DEPTH, D_MODEL))
    w_in = nrm(ks[3], (DEPTH, D_MODEL, N_IN), D_MODEL ** -0.5)
    conv_w = nrm(ks[4], (DEPTH, CONV_K, GDN_CONV_DIM), CONV_K ** -0.5)
    a_log = jnp.log(jax.random.uniform(ks[5], (DEPTH, GDN_HEADS), f32, 1.0, 16.0))
    dt = jnp.exp(jax.random.uniform(ks[6], (DEPTH, GDN_HEADS), f32, math.log(1e-3), math.log(1e-1)))
    dt_bias = dt + jnp.log(-jnp.expm1(-dt))
    gdn_norm_g = gain(ks[7], (DEPTH, GDN_DV))
    w_o_gdn = nrm(ks[8], (DEPTH, GDN_V, D_MODEL), GDN_V ** -0.5)
    fox_q_norm_g = gain(ks[9], (DEPTH, FOX_DH))
    fox_k_norm_g = gain(ks[10], (DEPTH, FOX_DH))
    fox_f_bias = jax.random.uniform(ks[11], (DEPTH, FOX_HEADS), f32, 3.0, 6.0)
    w_o_fox = nrm(ks[12], (DEPTH, FOX_W, D_MODEL), FOX_W ** -0.5)
    w_out = nrm(ks[13], (DEPTH, D_MODEL, D_MODEL), D_MODEL ** -0.5)
    mlp_norm_g = gain(ks[14], (DEPTH, D_MODEL))
    w_up = nrm(ks[15], (DEPTH, D_MODEL, D_FF), D_MODEL ** -0.5)
    w_down = nrm(ks[16], (DEPTH, D_FF, D_MODEL), D_FF ** -0.5)
    final_norm_g = gain(ks[17], (D_MODEL,))
    return {"x": x, "meta_tokens": meta_tokens, "mix_norm_g": mix_norm_g, "w_in": w_in,
            "conv_w": conv_w, "a_log": a_log, "dt_bias": dt_bias, "gdn_norm_g": gdn_norm_g,
            "w_o_gdn": w_o_gdn, "fox_q_norm_g": fox_q_norm_g, "fox_k_norm_g": fox_k_norm_g,
            "fox_f_bias": fox_f_bias, "w_o_fox": w_o_fox, "w_out": w_out, "mlp_norm_g": mlp_norm_g,
            "w_up": w_up, "w_down": w_down, "final_norm_g": final_norm_g}


def reference(x, meta_tokens, mix_norm_g, w_in, conv_w, a_log, dt_bias, gdn_norm_g, w_o_gdn,
              fox_q_norm_g, fox_k_norm_g, fox_f_bias, w_o_fox, w_out, mlp_norm_g, w_up, w_down,
              final_norm_g):
    B = x.shape[0]
    meta = jnp.broadcast_to(meta_tokens[None].astype(x.dtype), (B, N_META, D_MODEL))
    h = jnp.concatenate([meta, x], axis=1)
    for l in range(DEPTH):
        h = hybrid_layer(h, mix_norm_g[l], w_in[l], conv_w[l], a_log[l], dt_bias[l], gdn_norm_g[l],
                         w_o_gdn[l], fox_q_norm_g[l], fox_k_norm_g[l], fox_f_bias[l], w_o_fox[l],
                         w_out[l], mlp_norm_g[l], w_up[l], w_down[l])
    return rms_norm(h, final_norm_g)[:, N_META:]
```

```cpp
#include <hip/hip_runtime.h>
#include <hip/hip_bf16.h>
#include <hip/hip_cooperative_groups.h>
#include <cstdio>
#include <cstdint>
namespace cg = cooperative_groups;

#define DI __device__ __forceinline__
#define LAS __attribute__((address_space(3)))
typedef unsigned short bf16_t;
typedef short bf16x8 __attribute__((ext_vector_type(8)));
typedef short s16x4 __attribute__((ext_vector_type(4)));
typedef float f32x4 __attribute__((ext_vector_type(4)));
typedef float f32x16 __attribute__((ext_vector_type(16)));
typedef unsigned u32x4 __attribute__((ext_vector_type(4)));
typedef unsigned u32x2 __attribute__((ext_vector_type(2)));

constexpr int DM = 2048, NH = 16, DH = 128, DFF = 8192, SEQ = 4096, NB = 2, NMETA = 16;
constexpr int LP = 4160;
constexpr int PADF = 48, XOFF = 64;
constexpr int RP = NB * LP;
constexpr int MX = NB * SEQ;
constexpr int NIN = 18480, NBIG = 18432, NSM = 48;
constexpr int NCH = 65;
constexpr float EPS = 1e-6f;

constexpr size_t SZ_ROWS_P = (size_t)RP * DM * 2;
constexpr size_t SZ_ROWS_X = (size_t)MX * DM * 2;
constexpr size_t O_CTL = 0, CTL_BYTES = 1u << 20;
constexpr size_t O_WTIN = CTL_BYTES;
constexpr size_t SZ_WTIN = (size_t)(NBIG + 64) * DM * 2;
constexpr size_t O_U = O_WTIN + SZ_WTIN;
constexpr size_t SZ_U = (size_t)(MX + NMETA) * DM * 2;
constexpr size_t O_GQN = O_WTIN, O_GKN = O_GQN + SZ_ROWS_P, O_GVN = O_GKN + SZ_ROWS_P;
static_assert(3 * SZ_ROWS_P <= SZ_WTIN + SZ_U, "alias");
constexpr size_t O_YA = O_GKN, O_YB = O_GVN;
constexpr size_t O_WOG = O_U + SZ_U;
constexpr size_t O_WOF = O_WOG + (size_t)DM * DM * 2;
constexpr size_t O_WOUT = O_WOF + (size_t)DM * DM * 2;
constexpr size_t O_WUP = O_WOUT + (size_t)DM * DM * 2;
constexpr size_t O_WDN = O_WUP + (size_t)DFF * DM * 2;
constexpr size_t O_GRAW = O_WDN + (size_t)DFF * DM * 2;
constexpr size_t SZ_RAW = (size_t)RP * 6144 * 2;
constexpr size_t O_WV = O_GRAW, O_WK = O_WV + SZ_ROWS_P, O_KT = O_WK + SZ_ROWS_P;
constexpr size_t O_A2 = O_GRAW;
constexpr size_t O_FRAW = O_GRAW + SZ_RAW;
constexpr size_t O_MIX = O_FRAW;
constexpr size_t O_HID = O_FRAW;
constexpr size_t O_FQN = O_FRAW, O_FKN = O_FRAW + SZ_ROWS_P, O_FVN = O_FRAW + 2 * SZ_ROWS_P;
constexpr size_t O_RSV = O_FRAW + SZ_RAW;
static_assert((size_t)MX * DFF * 2 <= SZ_RAW + 2 * SZ_ROWS_P, "alias hid");
constexpr size_t O_Z = O_RSV + 2 * SZ_ROWS_P;
constexpr size_t O_GA = O_Z + SZ_ROWS_X, O_GB = O_GA + SZ_ROWS_X;
constexpr size_t O_QK = O_GB + SZ_ROWS_X;
constexpr size_t O_SM = O_QK + (size_t)NB * NH * NCH * 64 * 64 * 2;
constexpr size_t O_BETA = O_SM + (size_t)RP * NSM * 4;
constexpr size_t SZ_SC = (size_t)NB * NH * LP * 4;
constexpr size_t O_GG = O_BETA + SZ_SC, O_FB = O_GG + SZ_SC, O_GC = O_FB + SZ_SC, WS_END = O_GC + SZ_SC;
constexpr int CW_QUEUE = 64;
constexpr int CW_SS1 = 1024;
constexpr int CW_SS2 = 1024 + 8192;
constexpr int CW_BAR = 32768;
constexpr int CW_SCAN = 45056;
constexpr int CW_PANEL = 40960;

constexpr int RING_BYTES = 131072;
constexpr int LDS_BYTES = 155648;
constexpr int MISC_OFF = LDS_BYTES - 256;

DI unsigned cvt_pk_bf16(float lo, float hi) { unsigned r; asm volatile("v_cvt_pk_bf16_f32 %0, %1, %2" : "=v"(r) : "v"(lo), "v"(hi)); return r; }
DI float bf2f(bf16_t v) { return __uint_as_float((unsigned)v << 16); }
DI bf16_t f2bf(float f) { return (bf16_t)(cvt_pk_bf16(f, 0.f) & 0xffffu); }
DI float wave_sum(float v) {
#pragma unroll
    for (int o = 1; o < 64; o <<= 1) v += __shfl_xor(v, o);
    return v;
}
#define DPP_ADD(v, ctrl) ((v) + __int_as_float(__builtin_amdgcn_update_dpp(0, __float_as_int(v), (ctrl), 0xf, 0xf, true)))
DI float sum16(float v) { v = DPP_ADD(v, 0xB1); v = DPP_ADD(v, 0x4E); v = DPP_ADD(v, 0x141); v = DPP_ADD(v, 0x140); return v; }
DI float sum4(float v) { v = DPP_ADD(v, 0xB1); v = DPP_ADD(v, 0x4E); return v; }
#define DPP_Z(v, ctrl, rmask) __int_as_float(__builtin_amdgcn_update_dpp(0, __float_as_int(v), (ctrl), (rmask), 0xf, true))
DI float wave_scan_incl(float v) {
    v += DPP_Z(v, 0x111, 0xf); v += DPP_Z(v, 0x112, 0xf); v += DPP_Z(v, 0x114, 0xf); v += DPP_Z(v, 0x118, 0xf);
    v += DPP_Z(v, 0x142, 0xa); v += DPP_Z(v, 0x143, 0xc);
    return v;
}
DI float sigmoidf_(float x) { return 1.f / (1.f + __expf(-x)); }

namespace pg8 {
constexpr int BM = 256, BK = 64, HALF = 128, HTB = HALF * BK * 2, STAGE_BYTES = 8 * HTB, NXCD = 8, WGM = 8;
__host__ __device__ __forceinline__ int lds_byte(int r, int c) { const int st = (r >> 4) * 2 + (c >> 5), rr = r & 15, cc = c & 31, ob = rr * 64 + cc * 2; return st * 1024 + (ob ^ (((ob >> 9) & 1) << 5)); }
__host__ __device__ __forceinline__ void stage_rc(int b, int& R, int& C) { const int st = b / 1024, sb = b % 1024, swz = sb ^ (((sb >> 9) & 1) << 5); R = (st >> 1) * 16 + swz / 64; C = (st & 1) * 32 + (swz % 64) / 2; }
__host__ __device__ __forceinline__ int perm32(int rho) { const int n = rho >> 4, i = rho & 15; return 8 * (i >> 2) + 4 * n + (i & 3); }
struct Unit { int pm, pn; };
struct Gemm { const bf16_t* A; const bf16_t* Bt; int M, N, K; int asplit; size_t aoff2; };
struct StaticOrder {
    int nM, nN, nwg, G, c;
    __device__ void init(int M, int N, int G_, int c_) { nM = M / BM; nN = N / BM; nwg = nM * nN; G = G_; c = c_; }
    __device__ bool next(int i, Unit& u) const {
        const long L = (long)i * G + c; if (L >= nwg) return false;
        int wgid = (int)L; { const int q = nwg / NXCD, r = nwg % NXCD, xcd = wgid % NXCD, off = wgid / NXCD; wgid = (xcd < r ? xcd * (q + 1) : r * (q + 1) + (xcd - r) * q) + off; }
        const int nig = WGM * nN, gid = wgid / nig, fm = gid * WGM, gsz = (nM - fm) < WGM ? (nM - fm) : WGM;
        u.pm = fm + ((wgid % nig) % gsz); u.pn = (wgid % nig) / gsz; return true;
    }
};
struct PairOrder {
    int nM, nNo, G, c;
    __device__ bool next(int i, Unit& u) const {
        const int T = c + (i >> 1) * G; if (T >= nM * nNo) return false;
        if (G == 256 && nM == 32 && nNo == 8) { const int x = c & 7, off = c >> 3;
            u.pm = 8 * (x >> 1) + (off & 7); u.pn = 4 * (x & 1) + (off >> 3) + (i & 1) * nNo; return true; }
        u.pm = T / nNo; u.pn = (T % nNo) + (i & 1) * nNo; return true;
    }
};
template <class Epi, class Sched>
__device__ __forceinline__ void gemm_phase(LAS unsigned char* lds, const Gemm g, const Sched& S, const Epi& E) {
    int tid = threadIdx.x; asm volatile("" : "+v"(tid));
    const int wid = __builtin_amdgcn_readfirstlane(tid >> 6), lane = tid & 63, wr = wid >> 2, wc = wid & 3, fr = lane & 15, fq = lane >> 4;
    const int K = g.K, nt = K / BK;
    unsigned voffA[2], voffB[2];
#pragma unroll
    for (int i = 0; i < 2; ++i) { int R, C; stage_rc(tid * 16 + i * 8192, R, C); const int Rb = Epi::PERM ? ((R & ~31) + perm32(R & 31)) : R;
        voffA[i] = (unsigned)(R * K + C) * 2u; voffB[i] = (unsigned)(Rb * K + C) * 2u; }
    const size_t kstep = (size_t)(BK * 2);
    const size_t hstep = (size_t)HALF * K * 2;
    const size_t tstep = 2 * hstep;
    const unsigned ldsw = (unsigned)wid * 1024u;
    const int aoff = lds_byte(wr * 64 + fr, fq * 8), boff = lds_byte(wc * 32 + fr, fq * 8);
#define PG8_SA(b, h) (((b) * 2 + (h)) * HTB)
#define PG8_SB(b, h) ((4 + (b) * 2 + (h)) * HTB)
#define PG8_STAGE(bufoff, gbase, voff) do { _Pragma("unroll") for (int _i = 0; _i < 2; ++_i) \
        __builtin_amdgcn_global_load_lds((const unsigned*)((const char*)(gbase) + (voff)[_i]), (LAS unsigned*)(lds + (bufoff) + ldsw + _i * 8192), 16, 0, 0); } while (0)
#define PG8_LDA(dst, b, h) do { _Pragma("unroll") for (int m = 0; m < 4; ++m) _Pragma("unroll") for (int k = 0; k < 2; ++k) dst[m][k] = *(const LAS bf16x8*)(lds + PG8_SA(b, h) + aoff + m * 2048 + k * 1024); } while (0)
#define PG8_LDB(dst, b, h) do { _Pragma("unroll") for (int n = 0; n < 2; ++n) _Pragma("unroll") for (int k = 0; k < 2; ++k) dst[n][k] = *(const LAS bf16x8*)(lds + PG8_SB(b, h) + boff + n * 2048 + k * 1024); } while (0)
#define PG8_MMA(ai, bj, At, Bt) do { __builtin_amdgcn_s_setprio(1); _Pragma("unroll") for (int m = 0; m < 4; ++m) _Pragma("unroll") for (int n = 0; n < 2; ++n) _Pragma("unroll") for (int k = 0; k < 2; ++k) \
        acc[ai][bj][m][n] = __builtin_amdgcn_mfma_f32_16x16x32_bf16(Bt[n][k], At[m][k], acc[ai][bj][m][n], 0, 0, 0); __builtin_amdgcn_s_setprio(0); } while (0)
#define PG8_WAIT_V(n) asm volatile("s_waitcnt vmcnt(" #n ")" ::: "memory")
#define PG8_WAIT_L(n) asm volatile("s_waitcnt lgkmcnt(" #n ")" ::: "memory")
#define PG8_BAR __builtin_amdgcn_s_barrier()
#define PG8_SCHED __builtin_amdgcn_sched_barrier(0)
#define PG8_APTR(u) ((const char*)g.A + (size_t)(u).pm * tstep + ((u).pn >= g.asplit ? g.aoff2 : (size_t)0))
    Unit cur, nxt; int ui = 0;
    if (!S.next(0, cur)) return;
    f32x4 acc[2][2][4][2];
#pragma unroll
    for (int a = 0; a < 2; ++a)
#pragma unroll
        for (int b = 0; b < 2; ++b)
#pragma unroll
            for (int m = 0; m < 4; ++m)
#pragma unroll
                for (int n = 0; n < 2; ++n) acc[a][b][m][n] = (f32x4){0.f, 0.f, 0.f, 0.f};
    bf16x8 At[4][2], B0[2][2], B1[2][2];
    const char* cA = PG8_APTR(cur); const char* cB = (const char*)g.Bt + (size_t)cur.pn * tstep;
    PG8_STAGE(PG8_SB(0, 0), cB, voffB); PG8_STAGE(PG8_SB(0, 1), cB + hstep, voffB); PG8_STAGE(PG8_SA(0, 0), cA, voffA); PG8_STAGE(PG8_SA(0, 1), cA + hstep, voffA);
    if (wr == 1) PG8_BAR;
    PG8_WAIT_V(2); PG8_BAR;
    PG8_STAGE(PG8_SB(1, 0), cB + kstep, voffB); PG8_STAGE(PG8_SA(1, 0), cA + kstep, voffA); PG8_STAGE(PG8_SB(1, 1), cB + hstep + kstep, voffB);
    PG8_WAIT_V(6); PG8_BAR;
    for (;;) {
        const bool has_next = S.next(ui + 1, nxt);
        const char* nA = has_next ? PG8_APTR(nxt) : cA; const char* nB = has_next ? (const char*)g.Bt + (size_t)nxt.pn * tstep : cB;
        for (int t = 0; t < nt; t += 2) {
            const bool last = (t == nt - 2);
            const char* a1 = cA + (size_t)(t + 1) * kstep;
            const char* a2 = last ? nA : cA + (size_t)(t + 2) * kstep; const char* b2 = last ? nB : cB + (size_t)(t + 2) * kstep;
            const char* a3 = a2 + kstep; const char* b3 = b2 + kstep;
            PG8_LDB(B0, 0, 0); PG8_LDB(B1, 0, 1); PG8_SCHED; PG8_LDA(At, 0, 0); PG8_STAGE(PG8_SA(1, 1), a1 + hstep, voffA);
            PG8_WAIT_V(8); PG8_WAIT_L(0); PG8_BAR; PG8_MMA(0, 0, At, B0); PG8_MMA(0, 1, At, B1); PG8_BAR; PG8_SCHED;
            PG8_LDA(At, 0, 1); PG8_STAGE(PG8_SB(0, 0), b2, voffB); PG8_STAGE(PG8_SB(0, 1), b2 + hstep, voffB); PG8_STAGE(PG8_SA(0, 0), a2, voffA);
            PG8_WAIT_V(8); PG8_WAIT_L(0); PG8_BAR; PG8_MMA(1, 0, At, B0); PG8_MMA(1, 1, At, B1); PG8_BAR; PG8_SCHED;
            PG8_LDB(B0, 1, 0); PG8_LDB(B1, 1, 1); PG8_SCHED; PG8_LDA(At, 1, 0); PG8_STAGE(PG8_SA(0, 1), a2 + hstep, voffA);
            PG8_WAIT_V(8); PG8_WAIT_L(0); PG8_BAR; PG8_MMA(0, 0, At, B0); PG8_MMA(0, 1, At, B1); PG8_BAR; PG8_SCHED;
            PG8_LDA(At, 1, 1); PG8_STAGE(PG8_SB(1, 0), b3, voffB); PG8_STAGE(PG8_SB(1, 1), b3 + hstep, voffB); PG8_STAGE(PG8_SA(1, 0), a3, voffA);
            PG8_WAIT_V(8); PG8_WAIT_L(0); PG8_BAR; PG8_MMA(1, 0, At, B0); PG8_MMA(1, 1, At, B1); PG8_BAR; PG8_SCHED;
        }
        if (wr == 0) PG8_BAR;
        const bool keep = E(acc, cur, wr, wc, fr, fq);
        if (!has_next) break;
        if (!keep) {
#pragma unroll
        for (int a = 0; a < 2; ++a)
#pragma unroll
            for (int b = 0; b < 2; ++b)
#pragma unroll
                for (int m = 0; m < 4; ++m)
#pragma unroll
                    for (int n = 0; n < 2; ++n) acc[a][b][m][n] = (f32x4){0.f, 0.f, 0.f, 0.f};
        }
        cur = nxt; cA = nA; cB = nB; ++ui;
        if (wr == 1) PG8_BAR;
    }
    PG8_WAIT_V(0);
    PG8_BAR;
#undef PG8_SA
#undef PG8_SB
#undef PG8_STAGE
#undef PG8_LDA
#undef PG8_LDB
#undef PG8_MMA
#undef PG8_WAIT_V
#undef PG8_WAIT_L
#undef PG8_BAR
#undef PG8_SCHED
#undef PG8_APTR
}

struct EpiIn {
    static constexpr bool PERM = true;
    bf16_t *graw, *z, *fqn, *fkn, *fvn, *ga, *gb; const float *qg, *kg; LAS float* xch;
    __device__ __forceinline__ bool operator()(f32x4 (&acc)[2][2][4][2], const Unit& u, int wr, int wc, int fr, int fq) const {
        const int colt = u.pn * BM; const int bb = u.pm >> 4;
        bf16_t* base; int ldc, c0, roff = 0; bool sg = false; const float* ng = nullptr;
        if (colt < 6144) { base = graw; ldc = 6144; c0 = colt; roff = XOFF + 64 * bb; }
        else if (colt < 8192) { base = z; ldc = DM; c0 = colt - 6144; }
        else if (colt < 10240) { base = fqn; ldc = DM; c0 = colt - 8192; roff = XOFF + 64 * bb; ng = qg; }
        else if (colt < 12288) { base = fkn; ldc = DM; c0 = colt - 10240; roff = XOFF + 64 * bb; ng = kg; }
        else if (colt < 14336) { base = fvn; ldc = DM; c0 = colt - 12288; roff = XOFF + 64 * bb; }
        else if (colt < 16384) { base = ga; ldc = DM; c0 = colt - 14336; sg = true; }
        else { base = gb; ldc = DM; c0 = colt - 16384; sg = true; }
        const int row0 = u.pm * BM + wr * 64 + fr + roff, col0 = c0 + wc * 32 + 8 * fq;
        if (ng) {
#pragma unroll
            for (int ai = 0; ai < 2; ++ai)
#pragma unroll
                for (int m = 0; m < 4; ++m)
#pragma unroll
                    for (int bj = 0; bj < 2; ++bj) { const f32x4 v0 = acc[ai][bj][m][0], v1 = acc[ai][bj][m][1];
                        float s = ((v0[0] * v0[0] + v0[1] * v0[1]) + (v0[2] * v0[2] + v0[3] * v0[3])) + ((v1[0] * v1[0] + v1[1] * v1[1]) + (v1[2] * v1[2] + v1[3] * v1[3]));
                        s += __shfl_xor(s, 16); s += __shfl_xor(s, 32);
                        if (fq == 0) xch[(ai * HALF + wr * 64 + m * 16 + fr) * 8 + bj * 4 + wc] = s; }
            asm volatile("s_waitcnt lgkmcnt(0)" ::: "memory"); __builtin_amdgcn_s_barrier(); asm volatile("" ::: "memory");
            f32x4 g0 = *(const f32x4*)(ng + wc * 32 + 8 * fq), g1 = *(const f32x4*)(ng + wc * 32 + 8 * fq + 4);
#pragma unroll
            for (int ai = 0; ai < 2; ++ai)
#pragma unroll
                for (int m = 0; m < 4; ++m)
#pragma unroll
                    for (int bj = 0; bj < 2; ++bj) { const f32x4 p = *(const LAS f32x4*)(xch + (ai * HALF + wr * 64 + m * 16 + fr) * 8 + bj * 4);
                        const float rstd = rsqrtf(((p[0] + p[1]) + (p[2] + p[3])) * (1.f / DH) + EPS);
#pragma unroll
                        for (int e = 0; e < 4; ++e) { acc[ai][bj][m][0][e] *= rstd * g0[e]; acc[ai][bj][m][1][e] *= rstd * g1[e]; } }
        }
#pragma unroll
        for (int ai = 0; ai < 2; ++ai)
#pragma unroll
            for (int m = 0; m < 4; ++m) { bf16_t* rowp = base + (size_t)(row0 + ai * HALF + m * 16) * ldc + col0;
#pragma unroll
                for (int bj = 0; bj < 2; ++bj) { f32x4 v0 = acc[ai][bj][m][0], v1 = acc[ai][bj][m][1];
                    if (sg) {
#pragma unroll
                        for (int e = 0; e < 4; ++e) { v0[e] = sigmoidf_(v0[e]); v1[e] = sigmoidf_(v1[e]); } }
                    u32x4 w; w.x = cvt_pk_bf16(v0[0], v0[1]); w.y = cvt_pk_bf16(v0[2], v0[3]); w.z = cvt_pk_bf16(v1[0], v1[1]); w.w = cvt_pk_bf16(v1[2], v1[3]);
                    *(u32x4*)(rowp + bj * HALF) = w; } }
        return false;
    }
};
struct EpiMix {
    static constexpr bool PERM = true;
    const bf16_t *ga, *gb; bf16_t* mix;
    __device__ __forceinline__ bool operator()(f32x4 (&acc)[2][2][4][2], const Unit& u, int wr, int wc, int fr, int fq) const {
        const bool part1 = u.pn >= 8; const int colt = (part1 ? u.pn - 8 : u.pn) * BM;
        const int row0 = u.pm * BM + wr * 64 + fr, col0 = colt + wc * 32 + 8 * fq;
#pragma unroll
        for (int ai = 0; ai < 2; ++ai)
#pragma unroll
            for (int m = 0; m < 4; ++m) { const size_t off = (size_t)(row0 + ai * HALF + m * 16) * DM + col0;
#pragma unroll
                for (int bj = 0; bj < 2; ++bj) {
                    const bf16x8 gbv = *(const bf16x8*)(gb + off + bj * HALF);
                    if (!part1) { const bf16x8 gav = *(const bf16x8*)(ga + off + bj * HALF);
#pragma unroll
                        for (int e = 0; e < 8; ++e) { const float r = bf2f((bf16_t)gav[e]) / fmaxf(bf2f((bf16_t)gbv[e]), 1e-30f); acc[ai][bj][m][e >> 2][e & 3] *= r; } }
                    else { f32x4 v0 = acc[ai][bj][m][0], v1 = acc[ai][bj][m][1];
#pragma unroll
                        for (int e = 0; e < 4; ++e) { v0[e] *= bf2f((bf16_t)gbv[e]); v1[e] *= bf2f((bf16_t)gbv[4 + e]); }
                        u32x4 w; w.x = cvt_pk_bf16(v0[0], v0[1]); w.y = cvt_pk_bf16(v0[2], v0[3]); w.z = cvt_pk_bf16(v1[0], v1[1]); w.w = cvt_pk_bf16(v1[2], v1[3]);
                        *(u32x4*)(mix + off + bj * HALF) = w; } } }
        return !part1;
    }
};
struct EpiRes {
    static constexpr bool PERM = false;
    const float* base; float* out; bf16_t* a2; const float* gvec; float* ss;
    __device__ __forceinline__ bool operator()(f32x4 (&acc)[2][2][4][2], const Unit& u, int wr, int wc, int fr, int fq) const {
        const int row0 = u.pm * BM + wr * 64 + fr, col0 = u.pn * BM + wc * 32 + 4 * fq;
#pragma unroll
        for (int ai = 0; ai < 2; ++ai)
#pragma unroll
            for (int m = 0; m < 4; ++m) { const int row = row0 + ai * HALF + m * 16; const size_t off = (size_t)row * DM + col0; float s = 0.f;
#pragma unroll
                for (int bj = 0; bj < 2; ++bj)
#pragma unroll
                    for (int n = 0; n < 2; ++n) { const int co = bj * HALF + n * 16;
                        const f32x4 bs = *(const f32x4*)(base + off + co); const f32x4 o = bs + acc[ai][bj][m][n];
                        *(f32x4*)(out + off + co) = o; s += (o[0] * o[0] + o[1] * o[1]) + (o[2] * o[2] + o[3] * o[3]);
                        if (a2) { const f32x4 gv = *(const f32x4*)(gvec + col0 + co); u32x2 w; w.x = cvt_pk_bf16(o[0] * gv[0], o[1] * gv[1]); w.y = cvt_pk_bf16(o[2] * gv[2], o[3] * gv[3]);
                            *(u32x2*)(a2 + off + co) = w; } }
                s += __shfl_xor(s, 16); s += __shfl_xor(s, 32);
                if (fq == 0) atomicAdd(ss + row, s); }
        return false;
    }
};
struct EpiFinal {
    static constexpr bool PERM = false;
    const float* base; float* out; const float* gvec; float* ss; unsigned* cnt;
    __device__ __forceinline__ bool operator()(f32x4 (&acc)[2][2][4][2], const Unit& u, int wr, int wc, int fr, int fq) const {
        const int row0 = u.pm * BM + wr * 64 + fr, col0 = u.pn * BM + wc * 32 + 4 * fq;
#pragma unroll
        for (int ai = 0; ai < 2; ++ai)
#pragma unroll
            for (int m = 0; m < 4; ++m) { const int row = row0 + ai * HALF + m * 16; const size_t off = (size_t)row * DM + col0; float s = 0.f;
#pragma unroll
                for (int bj = 0; bj < 2; ++bj)
#pragma unroll
                    for (int n = 0; n < 2; ++n) { const int co = bj * HALF + n * 16;
                        const f32x4 bs = *(const f32x4*)(base + off + co); const f32x4 o = bs + acc[ai][bj][m][n]; acc[ai][bj][m][n] = o;
                        s += (o[0] * o[0] + o[1] * o[1]) + (o[2] * o[2] + o[3] * o[3]); }
                s += __shfl_xor(s, 16); s += __shfl_xor(s, 32);
                if (fq == 0) atomicAdd(ss + row, s); }
        asm volatile("s_waitcnt vmcnt(0)" ::: "memory");
        unsigned* cw = cnt + 64 * u.pm;
        if ((threadIdx.x & 63) == 0) __hip_atomic_fetch_add(cw, 1u, __ATOMIC_RELAXED, __HIP_MEMORY_SCOPE_AGENT);
        { unsigned sp = 0; while ((unsigned)__builtin_amdgcn_readfirstlane((int)__hip_atomic_load(cw, __ATOMIC_RELAXED, __HIP_MEMORY_SCOPE_AGENT)) < 64u) { __builtin_amdgcn_s_sleep(2); if (++sp > (1u << 22)) break; } }
        __builtin_amdgcn_fence(__ATOMIC_ACQUIRE, "agent");
#pragma unroll
        for (int ai = 0; ai < 2; ++ai)
#pragma unroll
            for (int m = 0; m < 4; ++m) { const int row = row0 + ai * HALF + m * 16; const size_t off = (size_t)row * DM + col0;
                const float rstd = rsqrtf(__hip_atomic_load(ss + row, __ATOMIC_RELAXED, __HIP_MEMORY_SCOPE_AGENT) * (1.f / DM) + EPS);
#pragma unroll
                for (int bj = 0; bj < 2; ++bj)
#pragma unroll
                    for (int n = 0; n < 2; ++n) { const int co = bj * HALF + n * 16; const f32x4 gv = *(const f32x4*)(gvec + col0 + co);
                        f32x4 o = acc[ai][bj][m][n] * rstd; o[0] *= gv[0]; o[1] *= gv[1]; o[2] *= gv[2]; o[3] *= gv[3];
                        *(f32x4*)(out + off + co) = o; } }
        return false;
    }
};
struct EpiUp {
    static constexpr bool PERM = true;
    const float* ss; bf16_t* hid;
    __device__ __forceinline__ bool operator()(f32x4 (&acc)[2][2][4][2], const Unit& u, int wr, int wc, int fr, int fq) const {
        const int row0 = u.pm * BM + wr * 64 + fr, col0 = u.pn * BM + wc * 32 + 8 * fq;
#pragma unroll
        for (int ai = 0; ai < 2; ++ai)
#pragma unroll
            for (int m = 0; m < 4; ++m) { const int row = row0 + ai * HALF + m * 16; const float rstd = rsqrtf(ss[row] * (1.f / DM) + EPS);
                bf16_t* rowp = hid + (size_t)row * DFF + col0;
#pragma unroll
                for (int bj = 0; bj < 2; ++bj) { f32x4 v0 = acc[ai][bj][m][0] * rstd, v1 = acc[ai][bj][m][1] * rstd;
#pragma unroll
                    for (int e = 0; e < 4; ++e) { const float a = fmaxf(v0[e], 0.f), b = fmaxf(v1[e], 0.f); v0[e] = a * a; v1[e] = b * b; }
                    u32x4 w; w.x = cvt_pk_bf16(v0[0], v0[1]); w.y = cvt_pk_bf16(v0[2], v0[3]); w.z = cvt_pk_bf16(v1[0], v1[1]); w.w = cvt_pk_bf16(v1[2], v1[3]);
                    *(u32x4*)(rowp + bj * HALF) = w; } }
        return false;
    }
};
}

namespace fox {
DI int ftid() { int t = threadIdx.x; asm volatile("" : "+v"(t)); return t; }
constexpr int D = 128, QS = DM, KS = DM, VS = DM, OS = DM;
constexpr float SCALE = 0.08838834764831845f, THR = 8.f;
constexpr int NW = 8, QBLK = 32, KVBLK = 64, QB = NW * QBLK;
constexpr int SHM_V = KVBLK * D * 2, SHM_K = KVBLK * D * 2;
constexpr int OFF_WS = 2 * SHM_V + 2 * SHM_K;
constexpr int OFF_BIAS = OFF_WS + NW * 64 * 4;
constexpr int BIAS_BYTES = LP * 4;
static_assert(OFF_BIAS + 2 * BIAS_BYTES <= RING_BYTES, "fox lds");
#define KSWZ(row, colB) ((row) * 256 + ((colB) ^ (((row) & 7) << 4)))
#define SBAR() __builtin_amdgcn_sched_barrier(0)
DI int v_st(int k, int c) { const int kk = (k & ~0xC) | ((k & 4) << 1) | ((k & 8) >> 1); return ((kk >> 3) * 4 + (c >> 5)) * 512 + ((kk & 7) * 32 + (c & 31)) * 2; }
DI int v_rd_base(int lane) { return ((lane & 3) << 3) | (((lane >> 2) & 3) << 6) | (((lane >> 4) & 1) << 5) | (((lane >> 5) & 1) << 8); }
constexpr int v_rd_off(int d0, int ks, int half) { return d0 * 512 + ks * 4096 + half * 2048; }
DI int crow(int r, int hi) { return (r & 3) + 8 * (r >> 2) + 4 * hi; }
DI bf16x8 load8(const bf16_t* p) { return *reinterpret_cast<const bf16x8*>(p); }
DI void mask_tile(f32x16& p0, f32x16& p1, int dq, unsigned W) {
    const float NEG = -__builtin_inff();
#pragma unroll
    for (int r = 0; r < 16; ++r) {
        const int c = (r & 3) + 8 * (r >> 2);
        if ((unsigned)(dq - c) >= W) p0[r] = NEG;
        if ((unsigned)(dq - c - 32) >= W) p1[r] = NEG;
    }
}
DI void partialSM(f32x16& p0, f32x16& p1, float& m_reg, float& mn, float& alpha) {
    float pmax = p0[0]; for (int r = 1; r < 16; ++r) pmax = fmaxf(pmax, p0[r]); for (int r = 0; r < 16; ++r) pmax = fmaxf(pmax, p1[r]);
    { auto rr = __builtin_amdgcn_permlane32_swap(__float_as_uint(pmax), __float_as_uint(pmax), false, false);
      pmax = fmaxf(__uint_as_float(rr[0]), __uint_as_float(rr[1])); }
    constexpr float C2 = 1.4426950408889634f * SCALE;
    if (__builtin_expect(__all((pmax - m_reg) * SCALE <= THR), 1)) { mn = m_reg; alpha = 1.f; }
    else { mn = fmaxf(m_reg, pmax); alpha = __builtin_amdgcn_exp2f((m_reg - mn) * C2); m_reg = mn; }
    const float mnL = -mn * C2;
    for (int r = 0; r < 16; ++r) p0[r] = fmaf(p0[r], C2, mnL); for (int r = 0; r < 16; ++r) p1[r] = fmaf(p1[r], C2, mnL);
    for (int r = 0; r < 16; ++r) p0[r] = __builtin_amdgcn_exp2f(p0[r]);
}
DI void finishSM(f32x16& p0, f32x16& p1, float alpha, float& l_reg, bf16x8& pa0, bf16x8& pa1, bf16x8& pa2, bf16x8& pa3) {
    for (int r = 0; r < 16; ++r) p1[r] = __builtin_amdgcn_exp2f(p1[r]);
    float ps = 0; for (int r = 0; r < 16; ++r) ps += p0[r]; for (int r = 0; r < 16; ++r) ps += p1[r];
    { auto rr = __builtin_amdgcn_permlane32_swap(__float_as_uint(ps), __float_as_uint(ps), false, false);
      ps = __uint_as_float(rr[0]) + __uint_as_float(rr[1]); }
    l_reg = l_reg * alpha + ps;
#define PK4(P, B_, OUT) do { unsigned a0 = cvt_pk_bf16(P[B_+0], P[B_+1]), a1 = cvt_pk_bf16(P[B_+2], P[B_+3]);                          \
        unsigned b0 = cvt_pk_bf16(P[B_+4], P[B_+5]), b1 = cvt_pk_bf16(P[B_+6], P[B_+7]);                                             \
        auto r0 = __builtin_amdgcn_permlane32_swap(a0, b0, false, false); auto r1 = __builtin_amdgcn_permlane32_swap(a1, b1, false, false); \
        u32x4 w = {r0[0], r1[0], r0[1], r1[1]}; OUT = *reinterpret_cast<bf16x8*>(&w); } while (0)
    PK4(p0, 0, pa0); PK4(p0, 8, pa1); PK4(p1, 0, pa2); PK4(p1, 8, pa3);
#undef PK4
}
template <int KB>
DI void qkt(f32x16& p0, f32x16& p1, const char* K_lds, const char* bias_t, int r32_in, int hi_in, const bf16x8* qr) {
    int l_ = threadIdx.x; asm volatile("" : "+v"(l_)); const int r32 = l_ & 31, hi = (l_ >> 5) & 1;
    { const char* bp = bias_t + 16 * hi;
#pragma unroll
      for (int gq = 0; gq < 4; ++gq) { const f32x4 a = *(const f32x4*)(bp + 32 * gq); const f32x4 b = *(const f32x4*)(bp + 128 + 32 * gq);
          p0[4 * gq] = a[0]; p0[4 * gq + 1] = a[1]; p0[4 * gq + 2] = a[2]; p0[4 * gq + 3] = a[3];
          p1[4 * gq] = b[0]; p1[4 * gq + 1] = b[1]; p1[4 * gq + 2] = b[2]; p1[4 * gq + 3] = b[3]; } }
    const char* kb[4];
#pragma unroll
    for (int dd = 0; dd < 4; ++dd) kb[dd] = K_lds + KB * SHM_K + KSWZ(r32, (dd * 16 + hi * 8) * 2);
#pragma unroll
    for (int d0 = 0; d0 < 8; ++d0) { const char* a = kb[d0 & 3] + (d0 >> 2) * 128;
        bf16x8 b0 = *reinterpret_cast<const bf16x8*>(a);
        bf16x8 b1 = *reinterpret_cast<const bf16x8*>(a + 32 * 256);
        p0 = __builtin_amdgcn_mfma_f32_32x32x16_bf16(b0, qr[d0], p0, 0, 0, 0);
        p1 = __builtin_amdgcn_mfma_f32_32x32x16_bf16(b1, qr[d0], p1, 0, 0, 0); }
}
template <int VB>
DI void pv_tile(f32x16* o, int vb0, bf16x8 pa0, bf16x8 pa1, bf16x8 pa2, bf16x8 pa3) {
#define TRRD(dst, off) asm volatile("ds_read_b64_tr_b16 %0, %1 offset:%2" : "=&v"(dst) : "v"(vb0), "i"(off) : "memory")
#define PV_D0(d0) do { s16x4 l0, l1, l2, l3, h0, h1, h2, h3; constexpr int b_ = VB * SHM_V + v_rd_off(d0, 0, 0); \
        TRRD(l0, b_); TRRD(h0, b_ + 2048); TRRD(l1, b_ + 4096); TRRD(h1, b_ + 6144); TRRD(l2, b_ + 8192); TRRD(h2, b_ + 10240); TRRD(l3, b_ + 12288); TRRD(h3, b_ + 14336); \
        asm volatile("s_waitcnt lgkmcnt(0)" ::: "memory"); SBAR();   \
        o[d0] = __builtin_amdgcn_mfma_f32_32x32x16_bf16(pa0, (bf16x8){l0[0], l0[1], l0[2], l0[3], h0[0], h0[1], h0[2], h0[3]}, o[d0], 0, 0, 0);   \
        o[d0] = __builtin_amdgcn_mfma_f32_32x32x16_bf16(pa1, (bf16x8){l1[0], l1[1], l1[2], l1[3], h1[0], h1[1], h1[2], h1[3]}, o[d0], 0, 0, 0);   \
        o[d0] = __builtin_amdgcn_mfma_f32_32x32x16_bf16(pa2, (bf16x8){l2[0], l2[1], l2[2], l2[3], h2[0], h2[1], h2[2], h2[3]}, o[d0], 0, 0, 0);   \
        o[d0] = __builtin_amdgcn_mfma_f32_32x32x16_bf16(pa3, (bf16x8){l3[0], l3[1], l3[2], l3[3], h3[0], h3[1], h3[2], h3[3]}, o[d0], 0, 0, 0); } while (0)
    PV_D0(0); PV_D0(1); PV_D0(2); PV_D0(3);
#undef PV_D0
#undef TRRD
}
struct BlockRef { const bf16_t* Q; const bf16_t* K; const bf16_t* V; bf16_t* O; const float* bias; int P0; };
struct Seam { bf16x8 qr[8]; bf16x8 st_v0, st_v1, st_k0, st_k1; };
#define LAUNDER(v) asm volatile("" : "+v"(v))
#define VMW() asm volatile("s_waitcnt vmcnt(0)" ::: "memory")
#define SLOAD_H(Kp, Vp, k0) do { int t_ = threadIdx.x; LAUNDER(t_); const int sr_ = t_ >> 4, sc_ = (t_ & 15) * 8;                   \
        const bf16_t* kp_ = (Kp) + (size_t)(k0) * KS; const bf16_t* vp_ = (Vp) + (size_t)(k0) * VS;                                 \
        const unsigned ok_ = (unsigned)(sr_ * KS + sc_), ov_ = (unsigned)(sr_ * VS + sc_);                                          \
        S.st_v0 = load8(vp_ + ov_); S.st_v1 = load8(vp_ + ov_ + 32 * VS); S.st_k0 = load8(kp_ + ok_); S.st_k1 = load8(kp_ + ok_ + 32 * KS); } while (0)
#define SWRITE_HK(bf) do { int t_ = threadIdx.x; LAUNDER(t_); const int sr_ = t_ >> 4, sc_ = (t_ & 15) * 8, kws_ = KSWZ(sr_, sc_ * 2);     \
        *(bf16x8*)(K_lds + (bf) * SHM_K + kws_) = S.st_k0; *(bf16x8*)(K_lds + (bf) * SHM_K + kws_ + 32 * 256) = S.st_k1; } while (0)
#define SWRITE_HV(bf) do { int t_ = threadIdx.x; LAUNDER(t_); const int sr_ = t_ >> 4, sc_ = (t_ & 15) * 8;                               \
        *(bf16x8*)(V_lds + (bf) * SHM_V + v_st(sr_, sc_)) = S.st_v0; *(bf16x8*)(V_lds + (bf) * SHM_V + v_st(32 + sr_, sc_)) = S.st_v1; } while (0)
#define SWRITE_H(bf) do { SWRITE_HV(bf); SWRITE_HK(bf); } while (0)
DI void bias_stage(const float* bias, char* lds, int par) {
    const int tid = ftid(), wid = __builtin_amdgcn_readfirstlane(tid >> 6);
    LAS unsigned char* dst = (LAS unsigned char*)lds + OFF_BIAS + par * BIAS_BYTES + wid * 1024;
    __builtin_amdgcn_global_load_lds((const unsigned*)(bias + tid * 4), (LAS unsigned*)dst, 16, 0, 0);
    __builtin_amdgcn_global_load_lds((const unsigned*)(bias + 2048 + tid * 4), (LAS unsigned*)(dst + 8192), 16, 0, 0);
    if (tid < 16) __builtin_amdgcn_global_load_lds((const unsigned*)(bias + 4096 + tid * 4), (LAS unsigned*)(dst + 16384), 16, 0, 0);
}
DI void causal_prime(const BlockRef& cur, char* lds, Seam& S, int par) {
    const int tid = ftid(), wid = __builtin_amdgcn_readfirstlane(tid >> 6), lane = tid & 63, r32 = lane & 31, hi = lane >> 5;
    char* K_lds = lds + 2 * SHM_V;
    bias_stage(cur.bias, lds, par);
    for (int d0 = 0; d0 < 8; ++d0) S.qr[d0] = load8(cur.Q + (unsigned)((wid * QBLK + r32) * QS + d0 * 16 + hi * 8));
    SLOAD_H(cur.K, cur.V, 0); VMW(); SWRITE_HK(0);
    __syncthreads();
}
DI void causal_block(const BlockRef& cur, const BlockRef& nxt, char* lds, Seam& S, int par) {
    const int tid = ftid(), wid = __builtin_amdgcn_readfirstlane(tid >> 6), lane = tid & 63, r32 = lane & 31, hi = lane >> 5;
    constexpr unsigned W = 1u << 30;
    const int NT = (cur.P0 + QB - 1) / KVBLK + 1;
    const int qlo = cur.P0 + wid * QBLK, qm = qlo + r32 - 4 * hi;
    char* V_lds = lds; char* K_lds = lds + 2 * SHM_V;
    float* ws = (float*)(lds + OFF_WS) + wid * 64; float* li_l = ws, * al_l = ws + 32;
    const char* bias_l = lds + OFF_BIAS + par * BIAS_BYTES;
    float m_reg = -1e30f, l_reg = 0; f32x16 o[4] = {};
    const int vb0 = (int)(uintptr_t)V_lds + v_rd_base(lane);
    const bf16_t* Kh = cur.K; const bf16_t* Vh = cur.V;
#define RESC(a) do { if (__any((a) < 1.f)) { if (hi == 0) al_l[r32] = (a); asm volatile("s_waitcnt lgkmcnt(0)" ::: "memory");              \
                     for (int d_ = 0; d_ < 4; ++d_) for (int r = 0; r < 16; ++r) o[d_][r] *= al_l[crow(r, hi)]; } } while (0)
#define KBASE(t) ((t) * KVBLK)
#define MASKT(P0_, P1_, t) do { const int kb_ = KBASE(t); if (kb_ + KVBLK - 1 > qlo) mask_tile(P0_, P1_, qm - kb_, W); } while (0)
#define BIAST(t) (bias_l + (t) * (KVBLK * 4))
    f32x16 pA0, pA1, pB0, pB1; float mnA, mnB, alA, alB; bf16x8 pa0, pa1, pa2, pa3;
    SWRITE_HV(0); SBAR();
    if (NT > 1) { SLOAD_H(Kh, Vh, KBASE(1)); }
    SBAR(); qkt<0>(pA0, pA1, K_lds, BIAST(0), r32, hi, S.qr);
    MASKT(pA0, pA1, 0); partialSM(pA0, pA1, m_reg, mnA, alA);
    if (NT > 1) { VMW(); SWRITE_H(1); }
    __syncthreads();
#define HALF_STEP(PX0, PX1, mnX, alX, PY0, PY1, alY, t, KB, VB, SB) do {                                                      \
        SBAR(); qkt<KB>(PX0, PX1, K_lds, BIAST(t), r32, hi, S.qr);                                             \
        finishSM(PY0, PY1, alY, l_reg, pa0, pa1, pa2, pa3); SBAR();                                                           \
        if ((t) + 1 < NT) { SLOAD_H(Kh, Vh, KBASE((t) + 1)); SBAR(); }                                               \
        pv_tile<VB>(o, vb0, pa0, pa1, pa2, pa3); MASKT(PX0, PX1, (t)); partialSM(PX0, PX1, m_reg, mnX, alX);                                        \
        __syncthreads();                                                                                                      \
        if ((t) + 1 < NT) { VMW(); SWRITE_H(SB); }                                                                          \
        RESC(alX); __syncthreads(); } while (0)
    for (int t = 1; t + 1 < NT; t += 2) {
        HALF_STEP(pB0, pB1, mnB, alB, pA0, pA1, alA, t, 1, 0, 0);
        HALF_STEP(pA0, pA1, mnA, alA, pB0, pB1, alB, t + 1, 0, 1, 1);
    }
    const bool even = (NT & 1) == 0;
    if (even) { SBAR(); qkt<1>(pB0, pB1, K_lds, BIAST(NT - 1), r32, hi, S.qr); SBAR(); }
    bias_stage(nxt.bias, lds, par ^ 1); SBAR();
    SLOAD_H(nxt.K, nxt.V, 0); SBAR();
#pragma unroll
    for (int d0 = 0; d0 < 8; ++d0) S.qr[d0] = load8(nxt.Q + (unsigned)((wid * QBLK + r32) * QS + d0 * 16 + hi * 8));
    SBAR();
    finishSM(pA0, pA1, alA, l_reg, pa0, pa1, pa2, pa3); SBAR();
    pv_tile<0>(o, vb0, pa0, pa1, pa2, pa3);
    if (even) { MASKT(pB0, pB1, NT - 1); partialSM(pB0, pB1, m_reg, mnB, alB); __syncthreads(); RESC(alB);
        finishSM(pB0, pB1, alB, l_reg, pa0, pa1, pa2, pa3); SBAR(); pv_tile<1>(o, vb0, pa0, pa1, pa2, pa3); }
    SBAR(); VMW(); SWRITE_HK(0); SBAR();
    if (hi == 0) li_l[r32] = l_reg; asm volatile("s_waitcnt lgkmcnt(0)" ::: "memory");
    float rli[16];
#pragma unroll
    for (int r = 0; r < 16; ++r) rli[r] = __builtin_amdgcn_rcpf(li_l[crow(r, hi)]);
    bf16_t* Ow = cur.O + (unsigned)(wid * QBLK * OS + r32);
#pragma unroll
    for (int r = 0; r < 16; ++r) { const int orow = crow(r, hi);
#pragma unroll
        for (int d0 = 0; d0 < 4; ++d0) { const float v = o[d0][r] * rli[r];
            const float vn = __shfl_xor(v, 1);
            if ((r32 & 1) == 0) *(unsigned*)(Ow + (unsigned)(orow * OS + d0 * 32)) = cvt_pk_bf16(v, vn); } }
    __syncthreads();
#undef RESC
#undef KBASE
#undef MASKT
#undef BIAST
#undef HALF_STEP
}
#undef LAUNDER
#undef VMW
#undef SLOAD_H
#undef SWRITE_HK
#undef SWRITE_HV
#undef SWRITE_H
#undef SBAR
#undef KSWZ
}

struct Args {
    const float *x, *meta, *mix_g, *w_in, *conv_w, *a_log, *dt_bias, *gdn_g, *w_o_gdn, *fox_qg, *fox_kg, *fox_fb, *w_o_fox, *w_out, *mlp_g, *w_up, *w_down, *final_g;
    float* out; unsigned char* ws;
};

DI void p0_transpose_item(const float* W, int K, int ldw, int src_c0, bf16_t* WT, int dst_r0, LAS float* scr, int kb, int nb, int lane) {
    const int k0 = 64 * kb, n0 = 32 * nb;
    const float* src = W + (size_t)(k0 + (lane >> 3)) * ldw + src_c0 + n0 + (lane & 7) * 4;
    f32x4 v[8];
#pragma unroll
    for (int i = 0; i < 8; ++i) v[i] = *(const f32x4*)(src + (size_t)(8 * i) * ldw);
#pragma unroll
    for (int i = 0; i < 8; ++i) { LAS float* d = scr + (8 * i + (lane >> 3)) * 33 + (lane & 7) * 4; d[0] = v[i][0]; d[1] = v[i][1]; d[2] = v[i][2]; d[3] = v[i][3]; }
    asm volatile("s_waitcnt lgkmcnt(0)" ::: "memory");
    const int c = lane & 7;
#pragma unroll
    for (int j = 0; j < 4; ++j) { const int n = (lane >> 3) + 8 * j; const LAS float* s = scr + (8 * c) * 33 + n;
        u32x4 o; o.x = cvt_pk_bf16(s[0 * 33], s[1 * 33]); o.y = cvt_pk_bf16(s[2 * 33], s[3 * 33]); o.z = cvt_pk_bf16(s[4 * 33], s[5 * 33]); o.w = cvt_pk_bf16(s[6 * 33], s[7 * 33]);
        *(u32x4*)(WT + (size_t)(dst_r0 + n0 + n) * K + k0 + 8 * c) = o; }
    asm volatile("s_waitcnt lgkmcnt(0)" ::: "memory");
}
DI void rms_row_to_bf16(const float* xrow, const float* g, bf16_t* orow, int lane) {
    const f32x4* xr = (const f32x4*)xrow + lane; const f32x4* gr = (const f32x4*)g + lane;
    f32x4 v[8]; float s = 0.f;
#pragma unroll
    for (int j = 0; j < 8; ++j) { v[j] = xr[64 * j]; s += (v[j].x * v[j].x + v[j].y * v[j].y) + (v[j].z * v[j].z + v[j].w * v[j].w); }
    const float rstd = rsqrtf(wave_sum(s) * (1.f / DM) + EPS);
    u32x2* o8 = (u32x2*)orow + lane;
#pragma unroll
    for (int j = 0; j < 8; ++j) { const f32x4 gg = gr[64 * j]; u32x2 w; w.x = cvt_pk_bf16(v[j].x * rstd * gg.x, v[j].y * rstd * gg.y); w.y = cvt_pk_bf16(v[j].z * rstd * gg.z, v[j].w * rstd * gg.w); o8[64 * j] = w; }
}
DI float log_sigmoid_(float x) { return fminf(x, 0.f) - log1pf(__expf(-fabsf(x))); }
DI float softplus_(float x) { return fmaxf(x, 0.f) + log1pf(__expf(-fabsf(x))); }
DI bf16x8 ld2x8(const bf16_t* p) { const s16x4 lo = *(const s16x4*)p; const s16x4 hi = *(const s16x4*)(p + 16); return __builtin_shufflevector(lo, hi, 0, 1, 2, 3, 4, 5, 6, 7); }
DI bf16x8 packacc(const f32x4 a, const f32x4 b) { u32x4 w = {cvt_pk_bf16(a[0], a[1]), cvt_pk_bf16(a[2], a[3]), cvt_pk_bf16(b[0], b[1]), cvt_pk_bf16(b[2], b[3])}; return __builtin_bit_cast(bf16x8, w); }
#define MFMA16(a, b, c) __builtin_amdgcn_mfma_f32_16x16x32_bf16((a), (b), (c), 0, 0, 0)
#define MFMA32(a, b, c) __builtin_amdgcn_mfma_f32_32x32x16_bf16((a), (b), (c), 0, 0, 0)

DI void glds16(const void* gsrc, unsigned lds_dst) { unsigned keep;
    asm volatile("s_mov_b32 %0, m0\n\ts_mov_b32 m0, %2\n\ts_nop 0\n\tglobal_load_lds_dwordx4 %1, off\n\ts_mov_b32 m0, %0" : "=&s"(keep) : "v"(gsrc), "s"(lds_dst) : "memory"); }

#define XB_TMO      128
#define XB_XCNT(j)  (256  + 64 * (j))
#define XB_XSUB(j)  (1280 + 64 * (j))
#define XB_XGEN(j)  (2304 + 64 * (j))
#define XB_TOP      3328
#define XB_TOPGEN   3392
#define XCD_BAR_WORDS 3456
#define XB_SPIN_CAP (1u << 18)
DI unsigned xb_ld(unsigned* p)              { return __hip_atomic_load(p, __ATOMIC_RELAXED, __HIP_MEMORY_SCOPE_AGENT); }
DI unsigned xb_add(unsigned* p, unsigned v) { return __hip_atomic_fetch_add(p, v, __ATOMIC_RELAXED, __HIP_MEMORY_SCOPE_AGENT); }
DI unsigned xb_xcc_id() { return (unsigned)__builtin_amdgcn_s_getreg((3 << 11) | 20) & 0xFu; }
#define XB_SPIN(cond, bar) do { unsigned _sp = 0; while (cond) { __builtin_amdgcn_s_sleep(1); \
    if ((++_sp & 255u) == 0u) { if (xb_ld(&(bar)[XB_TMO])) break; if (_sp > XB_SPIN_CAP) { atomicAdd(&(bar)[XB_TMO], 1u); break; } } } } while (0)
struct XcdBarrier { unsigned* bar; unsigned x; volatile LAS unsigned* st; };
DI XcdBarrier xcd_barrier_post(unsigned* bar, volatile LAS unsigned* st) {
    XcdBarrier b; b.bar = bar; b.x = xb_xcc_id(); b.st = st;
    if (threadIdx.x == 0) (void)xb_add(&bar[XB_XCNT(b.x)], 1u);
    return b;
}
DI void xcd_barrier_complete(unsigned* bar, unsigned x, unsigned& nloc, unsigned& nx) {
    const unsigned G = gridDim.x * gridDim.y * gridDim.z;
    unsigned sum, cnt, mine, sp = 0u;
    for (;;) {
        sum = 0u; cnt = 0u; mine = 0u;
#pragma unroll
        for (unsigned j = 0; j < 16; ++j) { const unsigned c = xb_ld(&bar[XB_XCNT(j)]); sum += c; cnt += (c > 0u) ? 1u : 0u; mine = (j == x) ? c : mine; }
        if (sum == G) break;
        __builtin_amdgcn_s_sleep(1);
        if ((++sp & 255u) == 0u) { if (xb_ld(&bar[XB_TMO])) break; if (sp > XB_SPIN_CAP) { atomicAdd(&bar[XB_TMO], 1u); break; } }
    }
    nloc = mine > 0u ? mine : 1u; nx = cnt > 0u ? cnt : 1u;
}
DI void xcd_barrier(const XcdBarrier& b) {
    asm volatile("s_waitcnt vmcnt(0)" ::: "memory");
    __syncthreads();
    if (threadIdx.x == 0) {
        unsigned* bar = b.bar;
        __builtin_amdgcn_s_waitcnt(0);
        unsigned nloc = b.st[0], nx = b.st[1];
        if (nloc == 0u) { xcd_barrier_complete(bar, b.x, nloc, nx); b.st[0] = nloc; b.st[1] = nx; }
        const unsigned old = xb_add(&bar[XB_XSUB(b.x)], 1u);
        const unsigned gen = old / nloc;
        if (old + 1u == (gen + 1u) * nloc) {
            __builtin_amdgcn_fence(__ATOMIC_RELEASE, "agent");
            asm volatile("s_waitcnt vmcnt(0)" ::: "memory");
            const unsigned og = xb_add(&bar[XB_TOP], 1u);
            const unsigned tg = og / nx;
            if (og + 1u == (tg + 1u) * nx) xb_add(&bar[XB_TOPGEN], 1u);
            else XB_SPIN(xb_ld(&bar[XB_TOPGEN]) == tg, bar);
            __builtin_amdgcn_fence(__ATOMIC_ACQUIRE, "agent");
            xb_add(&bar[XB_XGEN(b.x)], 1u);
            asm volatile("s_waitcnt vmcnt(0)" ::: "memory");
        } else {
            XB_SPIN(xb_ld(&bar[XB_XGEN(b.x)]) == gen, bar);
            __builtin_amdgcn_fence(__ATOMIC_ACQUIRE, "agent");
            asm volatile("s_waitcnt vmcnt(0)" ::: "memory");
        }
    }
    __syncthreads();
}
typedef const __attribute__((address_space(4))) Args CArgs;
#define PH_BEGIN \
    CArgs* ap = (CArgs*)__builtin_amdgcn_kernarg_segment_ptr(); asm volatile("" : "+s"(ap)); \
    int tid = threadIdx.x; asm volatile("" : "+v"(tid)); \
    const int lane = tid & 63, wave = __builtin_amdgcn_readfirstlane(tid >> 6); \
    const int G = gridDim.x, bx = blockIdx.x, gw = bx * 8 + wave, NGW = G * 8; \
    unsigned char* ws = ap->ws; LAS unsigned char* ldsl = (LAS unsigned char*)lds; \
    (void)lane; (void)wave; (void)gw; (void)NGW; (void)ws; (void)ldsl;
#define WSP(T, off) ((T*)(ws + (off)))

__global__ void __launch_bounds__(512) mk_fwd(Args args_unused) {
    extern __shared__ __attribute__((aligned(16))) unsigned char lds[];
    cg::grid_group grid = cg::this_grid();
    if (threadIdx.x < 64) ((LAS unsigned*)((LAS unsigned char*)lds + MISC_OFF))[threadIdx.x] = 0u;
    __syncthreads();
    const XcdBarrier xbar = xcd_barrier_post((unsigned*)(((CArgs*)__builtin_amdgcn_kernarg_segment_ptr())->ws + O_CTL) + CW_BAR, (volatile LAS unsigned*)((LAS unsigned char*)lds + MISC_OFF) + 8);
    {
        PH_BEGIN
        bf16_t* WTIN = WSP(bf16_t, O_WTIN); bf16_t* U = WSP(bf16_t, O_U); bf16_t* WOG = WSP(bf16_t, O_WOG); bf16_t* WOF = WSP(bf16_t, O_WOF); bf16_t* WOUT = WSP(bf16_t, O_WOUT); bf16_t* WUP = WSP(bf16_t, O_WUP); bf16_t* WDN = WSP(bf16_t, O_WDN);
        LAS float* scr = (LAS float*)(ldsl + wave * 16384);
        constexpr int I_IN = 32 * (NBIG / 32);
        for (int it = gw; it < I_IN; it += NGW) {
            const int nbk = NBIG / 32, kb = it / nbk, nb = it % nbk; const int dr = nb * 32; int sc;
            if (dr < 6144) sc = dr; else if (dr < 8192) sc = dr; else if (dr < 14336) sc = dr - 8192 + 8224; else if (dr < 16384) sc = dr - 14336 + 14384; else sc = dr - 16384 + 16432;
            p0_transpose_item(ap->w_in, DM, NIN, sc, WTIN, dr, scr, kb, 0, lane);
        }
        for (int e = bx * 512 + tid; e < 64 * DM; e += G * 512) { const int j = e / DM, k = e % DM; float v = 0.f;
            if (j < 48) { const int sc = j < 16 ? 8192 + j : (j < 32 ? 8208 + (j - 16) : 14368 + (j - 32)); v = ap->w_in[(size_t)k * NIN + sc]; }
            WTIN[(size_t)(NBIG + j) * DM + k] = f2bf(v); }
        for (int m = gw; m < MX + NMETA; m += NGW) rms_row_to_bf16(m < MX ? ap->x + (size_t)m * DM : ap->meta + (size_t)(m - MX) * DM, ap->mix_g, U + (size_t)m * DM, lane);
    }
    grid.sync();

    {
        PH_BEGIN
        bf16_t* WTIN = WSP(bf16_t, O_WTIN); bf16_t* U = WSP(bf16_t, O_U); bf16_t* GRAW = WSP(bf16_t, O_GRAW); bf16_t* FQN = WSP(bf16_t, O_FQN); bf16_t* FKN = WSP(bf16_t, O_FKN); bf16_t* FVN = WSP(bf16_t, O_FVN); bf16_t* Z = WSP(bf16_t, O_Z); bf16_t* GA = WSP(bf16_t, O_GA); bf16_t* GB = WSP(bf16_t, O_GB); float* SM = WSP(float, O_SM);
        pg8::Gemm g{U, WTIN, MX, NBIG, DM, 1 << 30, 0}; pg8::StaticOrder S; S.init(MX, NBIG, G, bx);
        pg8::EpiIn E{GRAW, Z, FQN, FKN, FVN, GA, GB, ap->fox_qg, ap->fox_kg, (LAS float*)(ldsl + RING_BYTES)};
        pg8::gemm_phase<pg8::EpiIn, pg8::StaticOrder>(ldsl, g, S, E);
        const int m16 = lane & 15, g4 = lane >> 4;
        constexpr int T_META = 384 + 384 + 3, T_SMALL = MX / 16;
        const int gwm = wave * G + bx;
        for (int t = gwm; t < T_META + T_SMALL; t += NGW) {
            if (t < T_META) {
                int wrow, dcol; int kind;
                if (t < 384) { wrow = 16 * t; dcol = 16 * t; kind = 0; } else if (t < 768) { wrow = 8192 + 16 * (t - 384); dcol = 16 * (t - 384); kind = 1; } else { wrow = NBIG + 16 * (t - 768); dcol = 16 * (t - 768); kind = 2; }
                const bf16_t* ap = U + (size_t)(MX + m16) * DM + 8 * g4; const bf16_t* bp = WTIN + (size_t)(wrow + m16) * DM + 8 * g4;
                f32x4 acc = {0.f, 0.f, 0.f, 0.f};
                f32x4 accb = {0.f, 0.f, 0.f, 0.f};
#pragma unroll 8
                for (int kk = 0; kk < DM / 32; kk += 2) { acc = MFMA16(*(const bf16x8*)(ap + 32 * kk), *(const bf16x8*)(bp + 32 * kk), acc);
                    accb = MFMA16(*(const bf16x8*)(ap + 32 * kk + 32), *(const bf16x8*)(bp + 32 * kk + 32), accb); }
                acc += accb;
#pragma unroll
                for (int r = 0; r < 4; ++r) { const int mt = 4 * g4 + r;
#pragma unroll
                    for (int b = 0; b < NB; ++b) { const size_t rp = (size_t)b * LP + PADF + mt;
                        if (kind == 0) GRAW[rp * 6144 + dcol + m16] = f2bf(acc[r]); else if (kind == 1) { if (dcol >= 4096) FVN[rp * DM + dcol - 4096 + m16] = f2bf(acc[r]); else if (dcol >= 2048) FKN[rp * DM + dcol - 2048 + m16] = f2bf(acc[r]);   } else SM[rp * NSM + dcol + m16] = acc[r]; } }
            } else {
                const int rt = t - T_META;
                const bf16_t* ap = U + (size_t)(16 * rt + m16) * DM + 8 * g4; const bf16_t* bp = WTIN + (size_t)(NBIG + m16) * DM + 8 * g4;
                f32x4 a0 = {0.f, 0.f, 0.f, 0.f}, a1 = a0, a2 = a0;
#pragma unroll 8
                for (int kk = 0; kk < DM / 32; ++kk) { const bf16x8 av = *(const bf16x8*)(ap + 32 * kk);
                    a0 = MFMA16(av, *(const bf16x8*)(bp + 32 * kk), a0); a1 = MFMA16(av, *(const bf16x8*)(bp + 16 * DM + 32 * kk), a1); a2 = MFMA16(av, *(const bf16x8*)(bp + 32 * DM + 32 * kk), a2); }
#pragma unroll
                for (int r = 0; r < 4; ++r) { const int m = 16 * rt + 4 * g4 + r; const size_t rp = (size_t)m + XOFF + 64 * (m >> 12);
                    SM[rp * NSM + m16] = a0[r]; SM[rp * NSM + 16 + m16] = a1[r]; SM[rp * NSM + 32 + m16] = a2[r]; }
            }
        }
    }
    xcd_barrier(xbar);

    {
        PH_BEGIN
        bf16_t* GRAW = WSP(bf16_t, O_GRAW); bf16_t* FVN = WSP(bf16_t, O_FVN); bf16_t* GQN = WSP(bf16_t, O_GQN); bf16_t* GKN = WSP(bf16_t, O_GKN); bf16_t* GVN = WSP(bf16_t, O_GVN); bf16_t* FQN = WSP(bf16_t, O_FQN); bf16_t* FKN = WSP(bf16_t, O_FKN);
        float* SM = WSP(float, O_SM); float* BETA = WSP(float, O_BETA); float* GG = WSP(float, O_GG); float* FB = WSP(float, O_FB);
        const float QSC = 0.08838834764831845f;
#define LDROW(tp_) (((tp_) >= PADF) ? *(const u32x4*)(src + (size_t)(tp_) * 6144) : (u32x4){0u, 0u, 0u, 0u})
#define UNPK(dstf, u) do { dstf[0] = __uint_as_float(u.x << 16); dstf[1] = __uint_as_float(u.x & 0xffff0000u); dstf[2] = __uint_as_float(u.y << 16); dstf[3] = __uint_as_float(u.y & 0xffff0000u); \
                           dstf[4] = __uint_as_float(u.z << 16); dstf[5] = __uint_as_float(u.z & 0xffff0000u); dstf[6] = __uint_as_float(u.w << 16); dstf[7] = __uint_as_float(u.w & 0xffff0000u); } while (0)
        for (int it = gw; it < 640 * 12; it += NGW) {
            const int strip = it / 12, cgp = it % 12; const int b = strip / 320, tp0 = (strip % 320) * 13;
            const int ch0 = cgp * 512 + lane * 8;
            float cw[4][8];
#pragma unroll
            for (int k = 0; k < 4; ++k) { const f32x4 a = *(const f32x4*)(ap->conv_w + k * 6144 + ch0), c = *(const f32x4*)(ap->conv_w + k * 6144 + ch0 + 4);
                cw[k][0] = a[0]; cw[k][1] = a[1]; cw[k][2] = a[2]; cw[k][3] = a[3]; cw[k][4] = c[0]; cw[k][5] = c[1]; cw[k][6] = c[2]; cw[k][7] = c[3]; }
            const bf16_t* src = GRAW + (size_t)b * LP * 6144 + ch0;
            bf16_t* dst = (cgp < 4 ? GQN : (cgp < 8 ? GKN : GVN)) + (size_t)b * LP * DM + (cgp & 3) * 512 + lane * 8;
            u32x4 ur[16];
#pragma unroll
            for (int i = 0; i < 16; ++i) ur[i] = LDROW(tp0 - 3 + i);
            float x0[8], x1[8], x2[8];
            UNPK(x0, ur[0]); UNPK(x1, ur[1]); UNPK(x2, ur[2]);
#pragma unroll
            for (int i = 0; i < 13; ++i) { const int tp = tp0 + i; float x3[8], y[8]; UNPK(x3, ur[3 + i]); float ssq = 0.f;
#pragma unroll
                for (int e = 0; e < 8; ++e) { const float c = cw[0][e] * x0[e] + cw[1][e] * x1[e] + cw[2][e] * x2[e] + cw[3][e] * x3[e]; y[e] = c * __builtin_amdgcn_rcpf(1.f + __expf(-c)); ssq += y[e] * y[e]; }
                if (cgp < 8) { ssq = sum16(ssq);
                    const float sc = rsqrtf(ssq + EPS) * (cgp < 4 ? QSC : 1.f);
#pragma unroll
                    for (int e = 0; e < 8; ++e) y[e] *= sc; }
                u32x4 w; w.x = cvt_pk_bf16(y[0], y[1]); w.y = cvt_pk_bf16(y[2], y[3]); w.z = cvt_pk_bf16(y[4], y[5]); w.w = cvt_pk_bf16(y[6], y[7]);
                *(u32x4*)(dst + (size_t)tp * DM) = w;
#pragma unroll
                for (int e = 0; e < 8; ++e) { x0[e] = x1[e]; x1[e] = x2[e]; x2[e] = x3[e]; } }
        }
        for (int it = gw; it < NB * XOFF; it += NGW) {
            const int b = it / XOFF, tp = it % XOFF; const size_t rp = (size_t)b * LP + tp;
            bf16_t* kd = FKN + rp * DM + lane * 32;
            if (tp < PADF) { bf16_t* vd = FVN + rp * DM + lane * 32;
#pragma unroll
                for (int i = 0; i < 4; ++i) { *(u32x4*)(kd + 8 * i) = (u32x4){0u, 0u, 0u, 0u}; *(u32x4*)(vd + 8 * i) = (u32x4){0u, 0u, 0u, 0u}; }
                continue; }
            const float* gp = ap->fox_kg + (lane & 3) * 32;
            float v[32]; float ssq = 0.f;
#pragma unroll
            for (int i = 0; i < 4; ++i) { const u32x4 u = *(const u32x4*)(kd + 8 * i); float f[8]; UNPK(f, u);
#pragma unroll
                for (int e = 0; e < 8; ++e) { v[8 * i + e] = f[e]; ssq += f[e] * f[e]; } }
            ssq = sum4(ssq);
            const float rstd = rsqrtf(ssq * (1.f / DH) + EPS);
#pragma unroll
            for (int i = 0; i < 4; ++i) { const f32x4 g0 = *(const f32x4*)(gp + 8 * i), g1 = *(const f32x4*)(gp + 8 * i + 4); u32x4 w;
                w.x = cvt_pk_bf16(v[8 * i] * rstd * g0[0], v[8 * i + 1] * rstd * g0[1]); w.y = cvt_pk_bf16(v[8 * i + 2] * rstd * g0[2], v[8 * i + 3] * rstd * g0[3]);
                w.z = cvt_pk_bf16(v[8 * i + 4] * rstd * g1[0], v[8 * i + 5] * rstd * g1[1]); w.w = cvt_pk_bf16(v[8 * i + 6] * rstd * g1[2], v[8 * i + 7] * rstd * g1[3]);
                *(u32x4*)(kd + 8 * i) = w; }
        }
#undef LDROW
#undef UNPK
        for (int e = bx * 512 + tid; e < NB * NH * LP; e += G * 512) {
            const int bh = e / LP, tp = e % LP, b = bh >> 4, h = bh & 15; float be = 0.f, gg = 0.f;
            if (tp >= PADF) { const float* sm = SM + ((size_t)b * LP + tp) * NSM; be = sigmoidf_(sm[h]); gg = -__expf(ap->a_log[h]) * softplus_(sm[16 + h] + ap->dt_bias[h]); }
            BETA[e] = be; GG[e] = gg; }
        { const int gwm = wave * G + bx;
          for (int bh = gwm; bh < NB * NH; bh += NGW) { const int b = bh >> 4, h = bh & 15; const float fbias = ap->fox_fb[h]; float carry = 0.f;
            float fv[NCH];
#pragma unroll
            for (int i = 0; i < NCH; ++i) { const int tp = i * 64 + lane; fv[i] = (tp >= PADF) ? SM[((size_t)b * LP + tp) * NSM + 32 + h] : 0.f; }
#pragma unroll
            for (int i = 0; i < NCH; ++i) { const int tp = i * 64 + lane; float v = (tp >= PADF) ? log_sigmoid_(fv[i] + fbias) : 0.f;
                v = wave_scan_incl(v);
                const float c = carry + v; carry = __int_as_float(__builtin_amdgcn_readlane(__float_as_int(c), 63));
                FB[(size_t)bh * LP + tp] = (tp >= PADF) ? -c * 11.313708498984761f : -__builtin_inff(); } } }
    }
    xcd_barrier(xbar);

    {
        PH_BEGIN
        bf16_t* GQN = WSP(bf16_t, O_GQN); bf16_t* GKN = WSP(bf16_t, O_GKN); bf16_t* GVN = WSP(bf16_t, O_GVN); bf16_t* WV = WSP(bf16_t, O_WV); bf16_t* WK = WSP(bf16_t, O_WK); bf16_t* KT = WSP(bf16_t, O_KT); bf16_t* QKB = WSP(bf16_t, O_QK);
        float* BETA = WSP(float, O_BETA); float* GG = WSP(float, O_GG); float* GC = WSP(float, O_GC);
        typedef float f32x2 __attribute__((ext_vector_type(2)));
        constexpr int UB = 53248;
        constexpr int NPAIR = NB * NH * NCH / 2;
        bf16_t* WUP = WSP(bf16_t, O_WUP); bf16_t* WDN = WSP(bf16_t, O_WDN); bf16_t* WOG = WSP(bf16_t, O_WOG); bf16_t* WOF = WSP(bf16_t, O_WOF); bf16_t* WOUT = WSP(bf16_t, O_WOUT);
        constexpr int I_UP = 32 * (DFF / 32), I_DN = 128 * (DM / 32), I_SQ = 32 * (DM / 32), NDEF = I_UP + I_DN + 3 * I_SQ;
        const int nslots = (NDEF + G - 1) / G; int dslot = wave - 4;
        LAS float* dscr = (LAS float*)(ldsl + 2 * UB + (wave & 3) * 8448);
#define DEFER_ITEMS(maxn_) do { for (int k_ = 0; k_ < (maxn_) && dslot < nslots; ++k_, dslot += 4) { const int id_ = dslot * G + bx; if (id_ < NDEF) {                       \
                if (id_ < I_UP) p0_transpose_item(ap->w_up, DM, DFF, 0, WUP, 0, dscr, id_ / (DFF / 32), id_ % (DFF / 32), lane);                                                  \
                else if (id_ < I_UP + I_DN) { const int r_ = id_ - I_UP; p0_transpose_item(ap->w_down, DFF, DM, 0, WDN, 0, dscr, r_ / (DM / 32), r_ % (DM / 32), lane); }                 \
                else { const int r_ = id_ - I_UP - I_DN, w_ = r_ / I_SQ, q_ = r_ % I_SQ;                                                                                              \
                    p0_transpose_item(w_ == 0 ? ap->w_o_gdn : (w_ == 1 ? ap->w_o_fox : ap->w_out), DM, DM, 0, w_ == 0 ? WOG : (w_ == 1 ? WOF : WOUT), 0, dscr, q_ / (DM / 32), q_ % (DM / 32), lane); } } } } while (0)
        for (int p = bx; p < NPAIR; p += G) {
            { const int half = tid >> 8, t = tid & 255, w4 = wave & 3;
              unsigned char* hb = lds + half * UB; float* Asm = (float*)hb; bf16_t* Ks = (bf16_t*)(hb + 16384); bf16_t* Vs = (bf16_t*)(hb + 32768); float* gcs = (float*)(hb + 49152); float* betas = gcs + 64; float* egs = gcs + 128;
              const int unit = 2 * p + half; const int bh = unit / NCH, n = unit % NCH, b = bh >> 4, h = bh & 15; const size_t R0 = (size_t)b * LP + 64 * n;
              if (w4 == 0) { float gv = GG[(size_t)bh * LP + 64 * n + lane]; const float be = BETA[(size_t)bh * LP + 64 * n + lane];
                  gv = wave_scan_incl(gv);
                  gcs[lane] = gv; betas[lane] = be; egs[lane] = __expf(gv); GC[(size_t)unit * 64 + lane] = gv; }
#pragma unroll
              for (int i = 0; i < 4; ++i) { const int ch = t + 256 * i, r = ch >> 4, c8 = (ch & 15) * 8;
                  *(u32x4*)(Ks + r * 128 + c8) = *(const u32x4*)(GKN + (R0 + r) * DM + h * 128 + c8);
                  *(u32x4*)(Vs + r * 128 + c8) = *(const u32x4*)(GVN + (R0 + r) * DM + h * 128 + c8); }
              const int qi = w4 >> 1, qj = w4 & 1, c = lane & 31, hi = lane >> 5;
              f32x16 mm = {}, qq = {};
              if (!(qi == 0 && qj == 1)) {
                  const bf16_t* ki = GKN + (R0 + 32 * qi + c) * DM + h * 128 + 8 * hi; const bf16_t* qi_ = GQN + (R0 + 32 * qi + c) * DM + h * 128 + 8 * hi;
                  const bf16_t* kj = GKN + (R0 + 32 * qj + c) * DM + h * 128 + 8 * hi;
#pragma unroll
                  for (int s = 0; s < 8; ++s) { const bf16x8 ak = *(const bf16x8*)(ki + 16 * s), aq = *(const bf16x8*)(qi_ + 16 * s), bk = *(const bf16x8*)(kj + 16 * s);
                      mm = MFMA32(ak, bk, mm); qq = MFMA32(aq, bk, qq); } }
              __syncthreads();
              bf16_t* qko = QKB + (size_t)unit * 4096; const int j = 32 * qj + c; const float gj = gcs[j];
#pragma unroll
              for (int r = 0; r < 16; ++r) { const int i = 32 * qi + fox::crow(r, hi); const float dec = __expf(gcs[i] - gj);
                  const float av = (i > j) ? betas[i] * mm[r] * dec : 0.f; const float qv = (i >= j) ? qq[r] * dec : 0.f;
                  Asm[i * 64 + j] = av; qko[i * 64 + j] = f2bf(qv); }
              __syncthreads(); }
            if (wave < 4) {
              const int u2 = wave >> 1, t = tid & 127;
              const unsigned char* hb = lds + u2 * UB; const float* Asm = (const float*)hb; const bf16_t* Ks = (const bf16_t*)(hb + 16384) + t; const bf16_t* Vs = (const bf16_t*)(hb + 32768) + t;
              const float* betas = (const float*)(hb + 49152) + 64; const float* egs = betas + 64;
              const int unit = 2 * p + u2;
              bf16_t* dv = WV + (size_t)unit * 8192 + t; bf16_t* dk = WK + (size_t)unit * 8192 + t;
              f32x2 w[64]; unsigned kpk[4]; bf16_t* kto = KT + (size_t)unit * 8192 + t * 64;
#pragma clang loop unroll(full)
              for (int i = 0; i < 64; ++i) {
                  const bf16_t kraw = Ks[i * 128]; const float be = betas[i];
                  f32x2 acc; acc.x = bf2f(Vs[i * 128]) * be; acc.y = bf2f(kraw) * be * egs[i];
                  if (i & 1) kpk[(i >> 1) & 3] |= (unsigned)kraw << 16; else kpk[(i >> 1) & 3] = kraw;
                  if ((i & 7) == 7) { u32x4 o; o.x = kpk[0]; o.y = kpk[1]; o.z = kpk[2]; o.w = kpk[3]; *(u32x4*)(kto + (i & ~7)) = o; }
                  const int arow = __float_as_int(Asm[i * 64 + lane]);
#pragma clang loop unroll(full)
                  for (int j0 = 0; j0 < 64; j0 += 8) {
                      if (j0 < i) {
                      float sc[8];
#pragma clang loop unroll(full)
                      for (int jj = 0; jj < 8; ++jj) sc[jj] = (j0 + jj < i) ? -__int_as_float(__builtin_amdgcn_readlane(arow, j0 + jj)) : 0.f;
#pragma clang loop unroll(full)
                      for (int jj = 0; jj < 8; ++jj) if (j0 + jj < i) { f32x2 s2; s2.x = sc[jj]; s2.y = sc[jj]; acc = __builtin_elementwise_fma(s2, w[j0 + jj], acc); }
                      }
                  }
                  w[i] = acc;
                  dv[i * 128] = f2bf(acc.x); dk[i * 128] = f2bf(acc.y); }
            } else { DEFER_ITEMS(6); }
            __syncthreads();
        }
        if (wave >= 4) { DEFER_ITEMS(1 << 30); }
#undef DEFER_ITEMS
    }
    xcd_barrier(xbar);

    {
        PH_BEGIN
        unsigned* ctl = WSP(unsigned, O_CTL);
        bf16_t* GQN = WSP(bf16_t, O_GQN); bf16_t* WV = WSP(bf16_t, O_WV); bf16_t* WK = WSP(bf16_t, O_WK); bf16_t* KT = WSP(bf16_t, O_KT); bf16_t* QKB = WSP(bf16_t, O_QK); float* GC = WSP(float, O_GC);
        bf16_t* Z = WSP(bf16_t, O_Z); bf16_t* YA = WSP(bf16_t, O_YA); bf16_t* YB = WSP(bf16_t, O_YB); bf16_t* FQN = WSP(bf16_t, O_FQN); bf16_t* FKN = WSP(bf16_t, O_FKN); bf16_t* FVN = WSP(bf16_t, O_FVN); float* FB = WSP(float, O_FB);
        if (bx < 2 * NB * NH) {
            const int bh = bx >> 1, half = bx & 1, b = bh >> 4, h = bh & 15, m16 = lane & 15, g4 = lane >> 4;
            constexpr int GBUF = 65792, G_WK = 0, G_Q = 16384, G_QK = 32768, G_KT = 40960, G_WV = 57344, G_GC = 65536;
            const unsigned lds0 = (unsigned)(uintptr_t)ldsl;
#define CROW(t_, i_) (32 * ((t_) >> 1) + 8 * ((i_) >> 2) + 4 * ((t_) & 1) + ((i_) & 3))
#define KEY256(row_) (((((row_) >> 3) & 3) << 2) | ((row_) & 3))
#define KEY128(row_) (((((row_) >> 3) & 3) << 1) | (((row_) >> 1) & 1))
            if (wave >= 4) {
                const int tl = tid - 256, lw = wave - 4;
                for (int n = 0; n < NCH; ++n) {
                    const int un_ = bh * NCH + n; const unsigned db_ = (unsigned)__builtin_amdgcn_readfirstlane((int)(lds0 + (n & 1) * GBUF + lw * 1024));
#pragma unroll
                    for (int r_ = 0; r_ < 4; ++r_) { const int P_ = r_ * 256 + tl;
                        { const int row_ = P_ >> 4, ch_ = (P_ & 15) ^ KEY256(row_);
                          glds16(WK + (size_t)un_ * 8192 + row_ * 128 + ch_ * 8, db_ + G_WK + r_ * 4096);
                          glds16(GQN + ((size_t)b * LP + 64 * n + row_) * DM + h * 128 + ch_ * 8, db_ + G_Q + r_ * 4096); }
                        { const int row_ = P_ >> 3, ch_ = (P_ & 7) ^ KEY128(row_);
                          glds16(KT + (size_t)un_ * 8192 + row_ * 64 + ch_ * 8, db_ + G_KT + r_ * 4096); } }
#pragma unroll
                    for (int r_ = 0; r_ < 2; ++r_) { const int P_ = r_ * 256 + tl, row_ = P_ >> 3, cs_ = P_ & 7;
                        glds16(QKB + (size_t)un_ * 4096 + row_ * 64 + (cs_ ^ KEY128(row_)) * 8, db_ + G_QK + r_ * 4096);
                        glds16(WV + (size_t)un_ * 8192 + row_ * 128 + half * 64 + cs_ * 8, db_ + G_WV + r_ * 4096); }
                    if (tl < 16) glds16(GC + (size_t)un_ * 64 + tl * 4, db_ + G_GC);
                    asm volatile("s_waitcnt vmcnt(0)" ::: "memory"); __builtin_amdgcn_s_barrier();
                }
                __builtin_amdgcn_s_barrier();
            } else {
                const int vl = 16 * wave;
#define FR256(tile_, ct_, ks_) (*(const LAS bf16x8*)((tile_) + CROW(ct_, m16) * 256 + (((4 * (ks_) + g4) ^ m16) << 4)))
#define FR128(tile_, t_, s2_) (*(const LAS bf16x8*)((tile_) + CROW(t_, m16) * 128 + (((4 * (s2_) + g4) ^ (((m16 >> 2) << 1) | ((m16 >> 1) & 1))) << 4)))
                f32x4 Sacc[8];
#pragma unroll
                for (int i = 0; i < 8; ++i) Sacc[i] = (f32x4){0.f, 0.f, 0.f, 0.f};
                constexpr float L2E = 1.4426950408889634f;
                __builtin_amdgcn_s_barrier();
                for (int n = 0; n < NCH; ++n) {
                    const LAS unsigned char* tb = ldsl + (n & 1) * GBUF;
                    const LAS float* gcl = (const LAS float*)(tb + G_GC); const LAS bf16_t* wvl = (const LAS bf16_t*)(tb + G_WV) + vl + m16;
                    bf16x8 Sb[4];
#pragma unroll
                    for (int ks = 0; ks < 4; ++ks) Sb[ks] = packacc(Sacc[2 * ks], Sacc[2 * ks + 1]);
                    f32x4 Uu[4], O1[4], gcv[4];
#pragma unroll
                    for (int ct = 0; ct < 4; ++ct) { Uu[ct] = (f32x4){0.f, 0.f, 0.f, 0.f}; O1[ct] = Uu[ct]; gcv[ct] = *(const LAS f32x4*)(gcl + CROW(ct, 4 * g4)) * L2E; }
                    const float gl = gcl[63] * L2E;
#pragma unroll
                    for (int ct = 0; ct < 4; ++ct) {
#pragma unroll
                        for (int ks = 0; ks < 4; ++ks) { Uu[ct] = MFMA16(FR256(tb + G_WK, ct, ks), Sb[ks], Uu[ct]); O1[ct] = MFMA16(FR256(tb + G_Q, ct, ks), Sb[ks], O1[ct]); }
                        __builtin_amdgcn_sched_barrier(0); }
                    f32x4 vn[4], vs[4];
#pragma unroll
                    for (int ct = 0; ct < 4; ++ct)
#pragma unroll
                        for (int r = 0; r < 4; ++r) { vn[ct][r] = bf2f(wvl[CROW(ct, 4 * g4 + r) * 64]) - Uu[ct][r];
                            O1[ct][r] *= __builtin_amdgcn_exp2f(gcv[ct][r]); vs[ct][r] = vn[ct][r] * __builtin_amdgcn_exp2f(gl - gcv[ct][r]); }
                    bf16x8 vnb[2], vsb[2];
#pragma unroll
                    for (int s2 = 0; s2 < 2; ++s2) { vnb[s2] = packacc(vn[2 * s2], vn[2 * s2 + 1]); vsb[s2] = packacc(vs[2 * s2], vs[2 * s2 + 1]); }
#pragma unroll
                    for (int ct = 0; ct < 4; ++ct) {
#pragma unroll
                        for (int s2 = 0; s2 < 2; ++s2) O1[ct] = MFMA16(FR128(tb + G_QK, ct, s2), vnb[s2], O1[ct]);
                        if (ct & 1) __builtin_amdgcn_sched_barrier(0); }
                    const float glast = __builtin_amdgcn_exp2f(gl);
#pragma unroll
                    for (int mt = 0; mt < 8; ++mt) { Sacc[mt] *= glast;
#pragma unroll
                        for (int s2 = 0; s2 < 2; ++s2) Sacc[mt] = MFMA16(FR128(tb + G_KT, mt, s2), vsb[s2], Sacc[mt]);
                        if ((mt & 3) == 3) __builtin_amdgcn_sched_barrier(0); }
                    if (n >= 1) {
                        bf16_t* op = YA + ((size_t)b * SEQ + 64 * (n - 1)) * DM + h * 128 + 64 * half + vl + m16;
#pragma unroll
                        for (int ct = 0; ct < 4; ++ct)
#pragma unroll
                            for (int r = 0; r < 4; ++r) op[(unsigned)(CROW(ct, 4 * g4 + r) * DM)] = f2bf(O1[ct][r]);
                    }
                    __builtin_amdgcn_s_barrier();
                }
#undef FR256
#undef FR128
            }
#undef CROW
#undef KEY256
#undef KEY128
            asm volatile("s_waitcnt vmcnt(0) lgkmcnt(0)" ::: "memory");
            __syncthreads();
            if (tid == 0) { __builtin_amdgcn_fence(__ATOMIC_RELEASE, "agent"); asm volatile("s_waitcnt vmcnt(0)" ::: "memory"); (void)xb_add(ctl + CW_SCAN, 1u); }
        }
        {
            volatile int* misc = (volatile int*)(lds + MISC_OFF);
            auto mkref = [&](int L) { const int v_ = L & 63, qb = 15 - (v_ >> 2), bh = (L >> 6) + 8 * (v_ & 3), b = bh >> 4, h = bh & 15; fox::BlockRef r;
                r.Q = FQN + ((size_t)b * LP + XOFF + qb * 256) * DM + h * 128; r.K = FKN + (size_t)b * LP * DM + h * 128; r.V = FVN + (size_t)b * LP * DM + h * 128;
                r.O = YB + ((size_t)b * SEQ + qb * 256) * DM + h * 128; r.bias = FB + (size_t)bh * LP; r.P0 = XOFF + qb * 256; return r; };
            const int xcd = (int)(__builtin_amdgcn_s_getreg((3 << 11) | 20) & 7u);
#define FOX_TAKE(slot_) do { if (tid == 0) { int code_ = -1; for (int q_ = 0; q_ < 8; ++q_) { const int x_ = (xcd + q_) & 7; const int v_ = (int)atomicAdd(ctl + CW_QUEUE + 64 * x_, 1u); if (v_ < 64) { code_ = x_ * 64 + v_; break; } } misc[slot_] = code_; } } while (0)
            FOX_TAKE(0);
            __syncthreads();
            int L = __builtin_amdgcn_readfirstlane(misc[0]);
            if (L >= 0) {
                fox::BlockRef cur = mkref(L); fox::Seam S; int par = 0;
                fox::causal_prime(cur, (char*)lds, S, par);
                for (;;) {
                    FOX_TAKE(1);
                    __syncthreads();
                    const int Ln = __builtin_amdgcn_readfirstlane(misc[1]); const bool last = Ln < 0;
                    const fox::BlockRef nxt = last ? cur : mkref(Ln);
                    fox::causal_block(cur, nxt, (char*)lds, S, par);
                    if (last) break;
                    cur = nxt; par ^= 1;
                }
            }
#undef FOX_TAKE
        }
        {
            { unsigned sp_ = 0; while ((unsigned)__builtin_amdgcn_readfirstlane((int)xb_ld(ctl + CW_SCAN)) < 64u) { __builtin_amdgcn_s_sleep(4); if (++sp_ > (1u << 22)) break; } }
            __builtin_amdgcn_fence(__ATOMIC_ACQUIRE, "agent");
        const int sub = lane >> 4, l16 = lane & 15;
        const f32x4 g0 = *(const f32x4*)(ap->gdn_g + l16 * 8), g1 = *(const f32x4*)(ap->gdn_g + l16 * 8 + 4);
        for (int it0 = gw; it0 < MX * NH / 4; it0 += 4 * NGW) {
            u32x4 ou[4], zu[4];
#pragma unroll
            for (int k = 0; k < 4; ++k) { const int it = it0 + k * NGW; const size_t off = (size_t)(it * 4 + sub) * 128 + l16 * 8;
                if (it < MX * NH / 4) { ou[k] = *(const u32x4*)(YA + off); zu[k] = *(const u32x4*)(Z + off); } else { ou[k] = (u32x4){0u, 0u, 0u, 0u}; zu[k] = ou[k]; } }
#pragma unroll
            for (int k = 0; k < 4; ++k) { const int it = it0 + k * NGW; const size_t off = (size_t)(it * 4 + sub) * 128 + l16 * 8;
                float o[8], z[8];
                o[0] = __uint_as_float(ou[k].x << 16); o[1] = __uint_as_float(ou[k].x & 0xffff0000u); o[2] = __uint_as_float(ou[k].y << 16); o[3] = __uint_as_float(ou[k].y & 0xffff0000u);
                o[4] = __uint_as_float(ou[k].z << 16); o[5] = __uint_as_float(ou[k].z & 0xffff0000u); o[6] = __uint_as_float(ou[k].w << 16); o[7] = __uint_as_float(ou[k].w & 0xffff0000u);
                z[0] = __uint_as_float(zu[k].x << 16); z[1] = __uint_as_float(zu[k].x & 0xffff0000u); z[2] = __uint_as_float(zu[k].y << 16); z[3] = __uint_as_float(zu[k].y & 0xffff0000u);
                z[4] = __uint_as_float(zu[k].z << 16); z[5] = __uint_as_float(zu[k].z & 0xffff0000u); z[6] = __uint_as_float(zu[k].w << 16); z[7] = __uint_as_float(zu[k].w & 0xffff0000u);
                float ss = 0.f;
#pragma unroll
                for (int e = 0; e < 8; ++e) ss += o[e] * o[e];
                ss = sum16(ss);
                const float rstd = rsqrtf(ss * (1.f / DH) + EPS);
                float y[8];
#pragma unroll
                for (int e = 0; e < 8; ++e) y[e] = o[e] * rstd * (e < 4 ? g0[e] : g1[e - 4]) * (z[e] * __builtin_amdgcn_rcpf(1.f + __expf(-z[e])));
                u32x4 w; w.x = cvt_pk_bf16(y[0], y[1]); w.y = cvt_pk_bf16(y[2], y[3]); w.z = cvt_pk_bf16(y[4], y[5]); w.w = cvt_pk_bf16(y[6], y[7]);
                if (it < MX * NH / 4) *(u32x4*)(YA + off) = w; }
        }
        }
    }
    xcd_barrier(xbar);

    {
        PH_BEGIN
        bf16_t* YA = WSP(bf16_t, O_YA); bf16_t* WOG = WSP(bf16_t, O_WOG); bf16_t* GA = WSP(bf16_t, O_GA); bf16_t* GB = WSP(bf16_t, O_GB); bf16_t* MIX = WSP(bf16_t, O_MIX);
        pg8::Gemm g{YA, WOG, MX, 2 * DM, DM, 8, (size_t)(O_YB - O_YA)}; pg8::PairOrder S{MX / 256, DM / 256, G, bx};
        pg8::EpiMix E{GA, GB, MIX};
        pg8::gemm_phase<pg8::EpiMix, pg8::PairOrder>(ldsl, g, S, E);
    }
    xcd_barrier(xbar);
    {
        PH_BEGIN
        bf16_t* MIX = WSP(bf16_t, O_MIX); bf16_t* WOUT = WSP(bf16_t, O_WOUT); bf16_t* A2 = WSP(bf16_t, O_A2); float* SS1 = (float*)(WSP(unsigned, O_CTL) + CW_SS1);
        pg8::Gemm g{MIX, WOUT, MX, DM, DM, 1 << 30, 0}; pg8::StaticOrder S; S.init(MX, DM, G, bx);
        pg8::EpiRes E{ap->x, ap->out, A2, ap->mlp_g, SS1};
        pg8::gemm_phase<pg8::EpiRes, pg8::StaticOrder>(ldsl, g, S, E);
    }
    xcd_barrier(xbar);
    {
        PH_BEGIN
        bf16_t* A2 = WSP(bf16_t, O_A2); bf16_t* WUP = WSP(bf16_t, O_WUP); bf16_t* HID = WSP(bf16_t, O_HID); float* SS1 = (float*)(WSP(unsigned, O_CTL) + CW_SS1);
        pg8::Gemm g{A2, WUP, MX, DFF, DM, 1 << 30, 0}; pg8::StaticOrder S; S.init(MX, DFF, G, bx);
        pg8::EpiUp E{SS1, HID};
        pg8::gemm_phase<pg8::EpiUp, pg8::StaticOrder>(ldsl, g, S, E);
    }
    xcd_barrier(xbar);
    {
        PH_BEGIN
        bf16_t* HID = WSP(bf16_t, O_HID); bf16_t* WDN = WSP(bf16_t, O_WDN); float* SS2 = (float*)(WSP(unsigned, O_CTL) + CW_SS2);
        pg8::Gemm g{HID, WDN, MX, DM, DFF, 1 << 30, 0}; pg8::StaticOrder S; S.init(MX, DM, G, bx);
        if (G == 256) { pg8::EpiFinal E{ap->out, ap->out, ap->final_g, SS2, WSP(unsigned, O_CTL) + CW_PANEL};
            pg8::gemm_phase<pg8::EpiFinal, pg8::StaticOrder>(ldsl, g, S, E); }
        else { pg8::EpiRes E{ap->out, ap->out, nullptr, nullptr, SS2};
            pg8::gemm_phase<pg8::EpiRes, pg8::StaticOrder>(ldsl, g, S, E); }
    }
    if (gridDim.x != 256) {
    xcd_barrier(xbar);
    {
        PH_BEGIN
        float* SS2 = (float*)(WSP(unsigned, O_CTL) + CW_SS2);
        for (int m = gw; m < MX; m += NGW) {
            const float rstd = rsqrtf(SS2[m] * (1.f / DM) + EPS);
            f32x4* o = (f32x4*)(ap->out + (size_t)m * DM) + lane; const f32x4* gr = (const f32x4*)ap->final_g + lane;
#pragma unroll
            for (int j = 0; j < 8; ++j) { f32x4 v = o[64 * j]; const f32x4 gg = gr[64 * j]; v = v * rstd; v[0] *= gg[0]; v[1] *= gg[1]; v[2] *= gg[2]; v[3] *= gg[3]; o[64 * j] = v; }
        }
    }
    }
}

extern "C" void kernel_launch(void* const* d_in, const int* in_sizes, int n_in, void* d_out, int out_size, void* d_ws, size_t ws_size, hipStream_t stream) {
    static int grid = 0;
    if (grid == 0) {
        if (n_in != 18 || in_sizes[0] != MX * DM || out_size != MX * DM || ws_size < WS_END) { fprintf(stderr, "kernel_launch: unexpected shapes (n_in %d, in0 %d, out %d, ws %zu < %zu)\n", n_in, n_in > 0 ? in_sizes[0] : -1, out_size, ws_size, (size_t)WS_END); grid = -1; return; }
        int dev = 0, cus = 0, per_cu = 0;
        (void)hipGetDevice(&dev); (void)hipDeviceGetAttribute(&cus, hipDeviceAttributeMultiprocessorCount, dev);
        if (hipFuncSetAttribute((const void*)mk_fwd, hipFuncAttributeMaxDynamicSharedMemorySize, LDS_BYTES) != hipSuccess) { fprintf(stderr, "kernel_launch: hipFuncSetAttribute failed\n"); grid = -1; return; }
        if (hipOccupancyMaxActiveBlocksPerMultiprocessor(&per_cu, (const void*)mk_fwd, 512, LDS_BYTES) != hipSuccess || per_cu < 1) { fprintf(stderr, "kernel_launch: occupancy query says %d\n", per_cu); per_cu = 1; }
        (void)hipGetLastError();
        grid = cus > 0 ? cus : 256;
    }
    if (grid < 0) return;
    (void)hipMemsetAsync((char*)d_ws + O_CTL, 0, CTL_BYTES, stream);
    Args a{};
    const float** p = (const float**)&a;
    for (int i = 0; i < 18; ++i) p[i] = (const float*)d_in[i];
    a.out = (float*)d_out; a.ws = (unsigned char*)d_ws;
    void* kargs[] = {&a};
    hipError_t e = hipLaunchCooperativeKernel((const void*)mk_fwd, dim3(grid), dim3(512), kargs, LDS_BYTES, stream);
    if (e != hipSuccess) fprintf(stderr, "kernel_launch: cooperative launch failed: %s (grid %d)\n", hipGetErrorString(e), grid);
}
```

```cpp
#include <hip/hip_runtime.h>
#include <hip/hip_bf16.h>
#include <hip/hip_cooperative_groups.h>
#include <cstdio>
#include <cstdint>
namespace cg = cooperative_groups;

#define DI __device__ __forceinline__
#define LAS __attribute__((address_space(3)))
typedef unsigned short bf16_t;
typedef short bf16x8 __attribute__((ext_vector_type(8)));
typedef short s16x4 __attribute__((ext_vector_type(4)));
typedef float f32x4 __attribute__((ext_vector_type(4)));
typedef float f32x16 __attribute__((ext_vector_type(16)));
typedef unsigned u32x4 __attribute__((ext_vector_type(4)));
typedef unsigned u32x2 __attribute__((ext_vector_type(2)));

constexpr int DM = 2048, NH = 16, DH = 128, DFF = 8192, SEQ = 4096, NB = 2, NMETA = 16;
constexpr int LP = 4160;
constexpr int PADF = 48, XOFF = 64;
constexpr int RP = NB * LP;
constexpr int MX = NB * SEQ;
constexpr int NIN = 18480, NBIG = 18432, NSM = 48;
constexpr int NCH = 65;
constexpr float EPS = 1e-6f;

constexpr size_t SZ_ROWS_P = (size_t)RP * DM * 2;
constexpr size_t SZ_ROWS_X = (size_t)MX * DM * 2;
constexpr size_t O_CTL = 0, CTL_BYTES = 1u << 20;
constexpr size_t O_WTIN = CTL_BYTES;
constexpr size_t SZ_WTIN = (size_t)(NBIG + 64) * DM * 2;
constexpr size_t O_U = O_WTIN + SZ_WTIN;
constexpr size_t SZ_U = (size_t)(MX + NMETA) * DM * 2;
constexpr size_t O_GQN = O_WTIN, O_GKN = O_GQN + SZ_ROWS_P, O_GVN = O_GKN + SZ_ROWS_P;
static_assert(3 * SZ_ROWS_P <= SZ_WTIN + SZ_U, "alias");
constexpr size_t O_YA = O_GKN, O_YB = O_GVN;
constexpr size_t O_WOG = O_U + SZ_U;
constexpr size_t O_WOF = O_WOG + (size_t)DM * DM * 2;
constexpr size_t O_WOUT = O_WOF + (size_t)DM * DM * 2;
constexpr size_t O_WUP = O_WOUT + (size_t)DM * DM * 2;
constexpr size_t O_WDN = O_WUP + (size_t)DFF * DM * 2;
constexpr size_t O_GRAW = O_WDN + (size_t)DFF * DM * 2;
constexpr size_t SZ_RAW = (size_t)RP * 6144 * 2;
constexpr size_t O_WV = O_GRAW, O_WK = O_WV + SZ_ROWS_P, O_KT = O_WK + SZ_ROWS_P;
constexpr size_t O_A2 = O_GRAW;
constexpr size_t O_FRAW = O_GRAW + SZ_RAW;
constexpr size_t O_MIX = O_FRAW;
constexpr size_t O_HID = O_FRAW;
constexpr size_t O_FQN = O_FRAW, O_FKN = O_FRAW + SZ_ROWS_P, O_FVN = O_FRAW + 2 * SZ_ROWS_P;
constexpr size_t O_RSV = O_FRAW + SZ_RAW;
static_assert((size_t)MX * DFF * 2 <= SZ_RAW + 2 * SZ_ROWS_P, "alias hid");
constexpr size_t O_Z = O_RSV + 2 * SZ_ROWS_P;
constexpr size_t O_GA = O_Z + SZ_ROWS_X, O_GB = O_GA + SZ_ROWS_X;
constexpr size_t O_QK = O_GB + SZ_ROWS_X;
constexpr size_t O_SM = O_QK + (size_t)NB * NH * NCH * 64 * 64 * 2;
constexpr size_t O_BETA = O_SM + (size_t)RP * NSM * 4;
constexpr size_t SZ_SC = (size_t)NB * NH * LP * 4;
constexpr size_t O_GG = O_BETA + SZ_SC, O_FB = O_GG + SZ_SC, O_GC = O_FB + SZ_SC, WS_END = O_GC + SZ_SC;
constexpr int CW_QUEUE = 64;
constexpr int CW_SS1 = 1024;
constexpr int CW_SS2 = 1024 + 8192;
constexpr int CW_BAR = 32768;
constexpr int CW_SCAN = 45056;
constexpr int CW_PANEL = 40960;

constexpr int RING_BYTES = 131072;
constexpr int LDS_BYTES = 155648;
constexpr int MISC_OFF = LDS_BYTES - 256;

DI unsigned cvt_pk_bf16(float lo, float hi) { unsigned r; asm volatile("v_cvt_pk_bf16_f32 %0, %1, %2" : "=v"(r) : "v"(lo), "v"(hi)); return r; }
DI float bf2f(bf16_t v) { return __uint_as_float((unsigned)v << 16); }
DI bf16_t f2bf(float f) { return (bf16_t)(cvt_pk_bf16(f, 0.f) & 0xffffu); }
DI float wave_sum(float v) {
#pragma unroll
    for (int o = 1; o < 64; o <<= 1) v += __shfl_xor(v, o);
    return v;
}
#define DPP_ADD(v, ctrl) ((v) + __int_as_float(__builtin_amdgcn_update_dpp(0, __float_as_int(v), (ctrl), 0xf, 0xf, true)))
DI float sum16(float v) { v = DPP_ADD(v, 0xB1); v = DPP_ADD(v, 0x4E); v = DPP_ADD(v, 0x141); v = DPP_ADD(v, 0x140); return v; }
DI float sum4(float v) { v = DPP_ADD(v, 0xB1); v = DPP_ADD(v, 0x4E); return v; }
#define DPP_Z(v, ctrl, rmask) __int_as_float(__builtin_amdgcn_update_dpp(0, __float_as_int(v), (ctrl), (rmask), 0xf, true))
DI float wave_scan_incl(float v) {
    v += DPP_Z(v, 0x111, 0xf); v += DPP_Z(v, 0x112, 0xf); v += DPP_Z(v, 0x114, 0xf); v += DPP_Z(v, 0x118, 0xf);
    v += DPP_Z(v, 0x142, 0xa); v += DPP_Z(v, 0x143, 0xc);
    return v;
}
DI float sigmoidf_(float x) { return 1.f / (1.f + __expf(-x)); }

namespace pg8 {
constexpr int BM = 256, BK = 64, HALF = 128, HTB = HALF * BK * 2, STAGE_BYTES = 8 * HTB, NXCD = 8, WGM = 8;
__host__ __device__ __forceinline__ int lds_byte(int r, int c) { const int st = (r >> 4) * 2 + (c >> 5), rr = r & 15, cc = c & 31, ob = rr * 64 + cc * 2; return st * 1024 + (ob ^ (((ob >> 9) & 1) << 5)); }
__host__ __device__ __forceinline__ void stage_rc(int b, int& R, int& C) { const int st = b / 1024, sb = b % 1024, swz = sb ^ (((sb >> 9) & 1) << 5); R = (st >> 1) * 16 + swz / 64; C = (st & 1) * 32 + (swz % 64) / 2; }
__host__ __device__ __forceinline__ int perm32(int rho) { const int n = rho >> 4, i = rho & 15; return 8 * (i >> 2) + 4 * n + (i & 3); }
struct Unit { int pm, pn; };
struct Gemm { const bf16_t* A; const bf16_t* Bt; int M, N, K; int asplit; size_t aoff2; };
struct StaticOrder {
    int nM, nN, nwg, G, c;
    __device__ void init(int M, int N, int G_, int c_) { nM = M / BM; nN = N / BM; nwg = nM * nN; G = G_; c = c_; }
    __device__ bool next(int i, Unit& u) const {
        const long L = (long)i * G + c; if (L >= nwg) return false;
        int wgid = (int)L; { const int q = nwg / NXCD, r = nwg % NXCD, xcd = wgid % NXCD, off = wgid / NXCD; wgid = (xcd < r ? xcd * (q + 1) : r * (q + 1) + (xcd - r) * q) + off; }
        const int nig = WGM * nN, gid = wgid / nig, fm = gid * WGM, gsz = (nM - fm) < WGM ? (nM - fm) : WGM;
        u.pm = fm + ((wgid % nig) % gsz); u.pn = (wgid % nig) / gsz; return true;
    }
};
struct PairOrder {
    int nM, nNo, G, c;
    __device__ bool next(int i, Unit& u) const {
        const int T = c + (i >> 1) * G; if (T >= nM * nNo) return false;
        if (G == 256 && nM == 32 && nNo == 8) { const int x = c & 7, off = c >> 3;
            u.pm = 8 * (x >> 1) + (off & 7); u.pn = 4 * (x & 1) + (off >> 3) + (i & 1) * nNo; return true; }
        u.pm = T / nNo; u.pn = (T % nNo) + (i & 1) * nNo; return true;
    }
};
template <class Epi, class Sched>
__device__ __forceinline__ void gemm_phase(LAS unsigned char* lds, const Gemm g, const Sched& S, const Epi& E) {
    int tid = threadIdx.x; asm volatile("" : "+v"(tid));
    const int wid = __builtin_amdgcn_readfirstlane(tid >> 6), lane = tid & 63, wr = wid >> 2, wc = wid & 3, fr = lane & 15, fq = lane >> 4;
    const int K = g.K, nt = K / BK;
    unsigned voffA[2], voffB[2];
#pragma unroll
    for (int i = 0; i < 2; ++i) { int R, C; stage_rc(tid * 16 + i * 8192, R, C); const int Rb = Epi::PERM ? ((R & ~31) + perm32(R & 31)) : R;
        voffA[i] = (unsigned)(R * K + C) * 2u; voffB[i] = (unsigned)(Rb * K + C) * 2u; }
    const size_t kstep = (size_t)(BK * 2);
    const size_t hstep = (size_t)HALF * K * 2;
    const size_t tstep = 2 * hstep;
    const unsigned ldsw = (unsigned)wid * 1024u;
    const int aoff = lds_byte(wr * 64 + fr, fq * 8), boff = lds_byte(wc * 32 + fr, fq * 8);
#define PG8_SA(b, h) (((b) * 2 + (h)) * HTB)
#define PG8_SB(b, h) ((4 + (b) * 2 + (h)) * HTB)
#define PG8_STAGE(bufoff, gbase, voff) do { _Pragma("unroll") for (int _i = 0; _i < 2; ++_i) \
        __builtin_amdgcn_global_load_lds((const unsigned*)((const char*)(gbase) + (voff)[_i]), (LAS unsigned*)(lds + (bufoff) + ldsw + _i * 8192), 16, 0, 0); } while (0)
#define PG8_LDA(dst, b, h) do { _Pragma("unroll") for (int m = 0; m < 4; ++m) _Pragma("unroll") for (int k = 0; k < 2; ++k) dst[m][k] = *(const LAS bf16x8*)(lds + PG8_SA(b, h) + aoff + m * 2048 + k * 1024); } while (0)
#define PG8_LDB(dst, b, h) do { _Pragma("unroll") for (int n = 0; n < 2; ++n) _Pragma("unroll") for (int k = 0; k < 2; ++k) dst[n][k] = *(const LAS bf16x8*)(lds + PG8_SB(b, h) + boff + n * 2048 + k * 1024); } while (0)
#define PG8_MMA(ai, bj, At, Bt) do { __builtin_amdgcn_s_setprio(1); _Pragma("unroll") for (int m = 0; m < 4; ++m) _Pragma("unroll") for (int n = 0; n < 2; ++n) _Pragma("unroll") for (int k = 0; k < 2; ++k) \
        acc[ai][bj][m][n] = __builtin_amdgcn_mfma_f32_16x16x32_bf16(Bt[n][k], At[m][k], acc[ai][bj][m][n], 0, 0, 0); __builtin_amdgcn_s_setprio(0); } while (0)
#define PG8_WAIT_V(n) asm volatile("s_waitcnt vmcnt(" #n ")" ::: "memory")
#define PG8_WAIT_L(n) asm volatile("s_waitcnt lgkmcnt(" #n ")" ::: "memory")
#define PG8_BAR __builtin_amdgcn_s_barrier()
#define PG8_SCHED __builtin_amdgcn_sched_barrier(0)
#define PG8_APTR(u) ((const char*)g.A + (size_t)(u).pm * tstep + ((u).pn >= g.asplit ? g.aoff2 : (size_t)0))
    Unit cur, nxt; int ui = 0;
    if (!S.next(0, cur)) return;
    f32x4 acc[2][2][4][2];
#pragma unroll
    for (int a = 0; a < 2; ++a)
#pragma unroll
        for (int b = 0; b < 2; ++b)
#pragma unroll
            for (int m = 0; m < 4; ++m)
#pragma unroll
                for (int n = 0; n < 2; ++n) acc[a][b][m][n] = (f32x4){0.f, 0.f, 0.f, 0.f};
    bf16x8 At[4][2], B0[2][2], B1[2][2];
    const char* cA = PG8_APTR(cur); const char* cB = (const char*)g.Bt + (size_t)cur.pn * tstep;
    PG8_STAGE(PG8_SB(0, 0), cB, voffB); PG8_STAGE(PG8_SB(0, 1), cB + hstep, voffB); PG8_STAGE(PG8_SA(0, 0), cA, voffA); PG8_STAGE(PG8_SA(0, 1), cA + hstep, voffA);
    if (wr == 1) PG8_BAR;
    PG8_WAIT_V(2); PG8_BAR;
    PG8_STAGE(PG8_SB(1, 0), cB + kstep, voffB); PG8_STAGE(PG8_SA(1, 0), cA + kstep, voffA); PG8_STAGE(PG8_SB(1, 1), cB + hstep + kstep, voffB);
    PG8_WAIT_V(6); PG8_BAR;
    for (;;) {
        const bool has_next = S.next(ui + 1, nxt);
        const char* nA = has_next ? PG8_APTR(nxt) : cA; const char* nB = has_next ? (const char*)g.Bt + (size_t)nxt.pn * tstep : cB;
        for (int t = 0; t < nt; t += 2) {
            const bool last = (t == nt - 2);
            const char* a1 = cA + (size_t)(t + 1) * kstep;
            const char* a2 = last ? nA : cA + (size_t)(t + 2) * kstep; const char* b2 = last ? nB : cB + (size_t)(t + 2) * kstep;
            const char* a3 = a2 + kstep; const char* b3 = b2 + kstep;
            PG8_LDB(B0, 0, 0); PG8_LDB(B1, 0, 1); PG8_SCHED; PG8_LDA(At, 0, 0); PG8_STAGE(PG8_SA(1, 1), a1 + hstep, voffA);
            PG8_WAIT_V(8); PG8_WAIT_L(0); PG8_BAR; PG8_MMA(0, 0, At, B0); PG8_MMA(0, 1, At, B1); PG8_BAR; PG8_SCHED;
            PG8_LDA(At, 0, 1); PG8_STAGE(PG8_SB(0, 0), b2, voffB); PG8_STAGE(PG8_SB(0, 1), b2 + hstep, voffB); PG8_STAGE(PG8_SA(0, 0), a2, voffA);
            PG8_WAIT_V(8); PG8_WAIT_L(0); PG8_BAR; PG8_MMA(1, 0, At, B0); PG8_MMA(1, 1, At, B1); PG8_BAR; PG8_SCHED;
            PG8_LDB(B0, 1, 0); PG8_LDB(B1, 1, 1); PG8_SCHED; PG8_LDA(At, 1, 0); PG8_STAGE(PG8_SA(0, 1), a2 + hstep, voffA);
            PG8_WAIT_V(8); PG8_WAIT_L(0); PG8_BAR; PG8_MMA(0, 0, At, B0); PG8_MMA(0, 1, At, B1); PG8_BAR; PG8_SCHED;
            PG8_LDA(At, 1, 1); PG8_STAGE(PG8_SB(1, 0), b3, voffB); PG8_STAGE(PG8_SB(1, 1), b3 + hstep, voffB); PG8_STAGE(PG8_SA(1, 0), a3, voffA);
            PG8_WAIT_V(8); PG8_WAIT_L(0); PG8_BAR; PG8_MMA(1, 0, At, B0); PG8_MMA(1, 1, At, B1); PG8_BAR; PG8_SCHED;
        }
        if (wr == 0) PG8_BAR;
        const bool keep = E(acc, cur, wr, wc, fr, fq);
        if (!has_next) break;
        if (!keep) {
#pragma unroll
        for (int a = 0; a < 2; ++a)
#pragma unroll
            for (int b = 0; b < 2; ++b)
#pragma unroll
                for (int m = 0; m < 4; ++m)
#pragma unroll
                    for (int n = 0; n < 2; ++n) acc[a][b][m][n] = (f32x4){0.f, 0.f, 0.f, 0.f};
        }
        cur = nxt; cA = nA; cB = nB; ++ui;
        if (wr == 1) PG8_BAR;
    }
    PG8_WAIT_V(0);
    PG8_BAR;
#undef PG8_SA
#undef PG8_SB
#undef PG8_STAGE
#undef PG8_LDA
#undef PG8_LDB
#undef PG8_MMA
#undef PG8_WAIT_V
#undef PG8_WAIT_L
#undef PG8_BAR
#undef PG8_SCHED
#undef PG8_APTR
}

struct EpiIn {
    static constexpr bool PERM = true;
    bf16_t *graw, *z, *fqn, *fkn, *fvn, *ga, *gb; const float *qg, *kg; LAS float* xch;
    __device__ __forceinline__ bool operator()(f32x4 (&acc)[2][2][4][2], const Unit& u, int wr, int wc, int fr, int fq) const {
        const int colt = u.pn * BM; const int bb = u.pm >> 4;
        bf16_t* base; int ldc, c0, roff = 0; bool sg = false; const float* ng = nullptr;
        if (colt < 6144) { base = graw; ldc = 6144; c0 = colt; roff = XOFF + 64 * bb; }
        else if (colt < 8192) { base = z; ldc = DM; c0 = colt - 6144; }
        else if (colt < 10240) { base = fqn; ldc = DM; c0 = colt - 8192; roff = XOFF + 64 * bb; ng = qg; }
        else if (colt < 12288) { base = fkn; ldc = DM; c0 = colt - 10240; roff = XOFF + 64 * bb; ng = kg; }
        else if (colt < 14336) { base = fvn; ldc = DM; c0 = colt - 12288; roff = XOFF + 64 * bb; }
        else if (colt < 16384) { base = ga; ldc = DM; c0 = colt - 14336; sg = true; }
        else { base = gb; ldc = DM; c0 = colt - 16384; sg = true; }
        const int row0 = u.pm * BM + wr * 64 + fr + roff, col0 = c0 + wc * 32 + 8 * fq;
        if (ng) {
#pragma unroll
            for (int ai = 0; ai < 2; ++ai)
#pragma unroll
                for (int m = 0; m < 4; ++m)
#pragma unroll
                    for (int bj = 0; bj < 2; ++bj) { const f32x4 v0 = acc[ai][bj][m][0], v1 = acc[ai][bj][m][1];
                        float s = ((v0[0] * v0[0] + v0[1] * v0[1]) + (v0[2] * v0[2] + v0[3] * v0[3])) + ((v1[0] * v1[0] + v1[1] * v1[1]) + (v1[2] * v1[2] + v1[3] * v1[3]));
                        s += __shfl_xor(s, 16); s += __shfl_xor(s, 32);
                        if (fq == 0) xch[(ai * HALF + wr * 64 + m * 16 + fr) * 8 + bj * 4 + wc] = s; }
            asm volatile("s_waitcnt lgkmcnt(0)" ::: "memory"); __builtin_amdgcn_s_barrier(); asm volatile("" ::: "memory");
            f32x4 g0 = *(const f32x4*)(ng + wc * 32 + 8 * fq), g1 = *(const f32x4*)(ng + wc * 32 + 8 * fq + 4);
#pragma unroll
            for (int ai = 0; ai < 2; ++ai)
#pragma unroll
                for (int m = 0; m < 4; ++m)
#pragma unroll
                    for (int bj = 0; bj < 2; ++bj) { const f32x4 p = *(const LAS f32x4*)(xch + (ai * HALF + wr * 64 + m * 16 + fr) * 8 + bj * 4);
                        const float rstd = rsqrtf(((p[0] + p[1]) + (p[2] + p[3])) * (1.f / DH) + EPS);
#pragma unroll
                        for (int e = 0; e < 4; ++e) { acc[ai][bj][m][0][e] *= rstd * g0[e]; acc[ai][bj][m][1][e] *= rstd * g1[e]; } }
        }
#pragma unroll
        for (int ai = 0; ai < 2; ++ai)
#pragma unroll
            for (int m = 0; m < 4; ++m) { bf16_t* rowp = base + (size_t)(row0 + ai * HALF + m * 16) * ldc + col0;
#pragma unroll
                for (int bj = 0; bj < 2; ++bj) { f32x4 v0 = acc[ai][bj][m][0], v1 = acc[ai][bj][m][1];
                    if (sg) {
#pragma unroll
                        for (int e = 0; e < 4; ++e) { v0[e] = __builtin_amdgcn_rcpf(1.f + __expf(-v0[e])); v1[e] = __builtin_amdgcn_rcpf(1.f + __expf(-v1[e])); } }
                    u32x4 w; w.x = cvt_pk_bf16(v0[0], v0[1]); w.y = cvt_pk_bf16(v0[2], v0[3]); w.z = cvt_pk_bf16(v1[0], v1[1]); w.w = cvt_pk_bf16(v1[2], v1[3]);
                    *(u32x4*)(rowp + bj * HALF) = w; } }
        return false;
    }
};
struct EpiMix {
    static constexpr bool PERM = true;
    const bf16_t *ga, *gb; bf16_t* mix;
    __device__ __forceinline__ bool operator()(f32x4 (&acc)[2][2][4][2], const Unit& u, int wr, int wc, int fr, int fq) const {
        const bool part1 = u.pn >= 8; const int colt = (part1 ? u.pn - 8 : u.pn) * BM;
        const int row0 = u.pm * BM + wr * 64 + fr, col0 = colt + wc * 32 + 8 * fq;
#pragma unroll
        for (int ai = 0; ai < 2; ++ai)
#pragma unroll
            for (int m = 0; m < 4; ++m) { const size_t off = (size_t)(row0 + ai * HALF + m * 16) * DM + col0;
#pragma unroll
                for (int bj = 0; bj < 2; ++bj) {
                    const bf16x8 gbv = *(const bf16x8*)(gb + off + bj * HALF);
                    if (!part1) { const bf16x8 gav = *(const bf16x8*)(ga + off + bj * HALF);
#pragma unroll
                        for (int e = 0; e < 8; ++e) { const float r = bf2f((bf16_t)gav[e]) / fmaxf(bf2f((bf16_t)gbv[e]), 1e-30f); acc[ai][bj][m][e >> 2][e & 3] *= r; } }
                    else { f32x4 v0 = acc[ai][bj][m][0], v1 = acc[ai][bj][m][1];
#pragma unroll
                        for (int e = 0; e < 4; ++e) { v0[e] *= bf2f((bf16_t)gbv[e]); v1[e] *= bf2f((bf16_t)gbv[4 + e]); }
                        u32x4 w; w.x = cvt_pk_bf16(v0[0], v0[1]); w.y = cvt_pk_bf16(v0[2], v0[3]); w.z = cvt_pk_bf16(v1[0], v1[1]); w.w = cvt_pk_bf16(v1[2], v1[3]);
                        *(u32x4*)(mix + off + bj * HALF) = w; } } }
        return !part1;
    }
};
struct EpiRes {
    static constexpr bool PERM = false;
    const float* base; float* out; bf16_t* a2; const float* gvec; float* ss;
    __device__ __forceinline__ bool operator()(f32x4 (&acc)[2][2][4][2], const Unit& u, int wr, int wc, int fr, int fq) const {
        const int row0 = u.pm * BM + wr * 64 + fr, col0 = u.pn * BM + wc * 32 + 4 * fq;
#pragma unroll
        for (int ai = 0; ai < 2; ++ai)
#pragma unroll
            for (int m = 0; m < 4; ++m) { const int row = row0 + ai * HALF + m * 16; const size_t off = (size_t)row * DM + col0; float s = 0.f;
#pragma unroll
                for (int bj = 0; bj < 2; ++bj)
#pragma unroll
                    for (int n = 0; n < 2; ++n) { const int co = bj * HALF + n * 16;
                        const f32x4 bs = *(const f32x4*)(base + off + co); const f32x4 o = bs + acc[ai][bj][m][n];
                        *(f32x4*)(out + off + co) = o; s += (o[0] * o[0] + o[1] * o[1]) + (o[2] * o[2] + o[3] * o[3]);
                        if (a2) { const f32x4 gv = *(const f32x4*)(gvec + col0 + co); u32x2 w; w.x = cvt_pk_bf16(o[0] * gv[0], o[1] * gv[1]); w.y = cvt_pk_bf16(o[2] * gv[2], o[3] * gv[3]);
                            *(u32x2*)(a2 + off + co) = w; } }
                s += __shfl_xor(s, 16); s += __shfl_xor(s, 32);
                if (fq == 0) atomicAdd(ss + row, s); }
        return false;
    }
};
struct EpiFinal {
    static constexpr bool PERM = false;
    const float* base; float* out; const float* gvec; float* ss; unsigned* cnt;
    __device__ __forceinline__ bool operator()(f32x4 (&acc)[2][2][4][2], const Unit& u, int wr, int wc, int fr, int fq) const {
        const int row0 = u.pm * BM + wr * 64 + fr, col0 = u.pn * BM + wc * 32 + 4 * fq;
#pragma unroll
        for (int ai = 0; ai < 2; ++ai)
#pragma unroll
            for (int m = 0; m < 4; ++m) { const int row = row0 + ai * HALF + m * 16; const size_t off = (size_t)row * DM + col0; float s = 0.f;
#pragma unroll
                for (int bj = 0; bj < 2; ++bj)
#pragma unroll
                    for (int n = 0; n < 2; ++n) { const int co = bj * HALF + n * 16;
                        const f32x4 bs = *(const f32x4*)(base + off + co); const f32x4 o = bs + acc[ai][bj][m][n]; acc[ai][bj][m][n] = o;
                        s += (o[0] * o[0] + o[1] * o[1]) + (o[2] * o[2] + o[3] * o[3]); }
                s += __shfl_xor(s, 16); s += __shfl_xor(s, 32);
                if (fq == 0) atomicAdd(ss + row, s); }
        asm volatile("s_waitcnt vmcnt(0)" ::: "memory");
        unsigned* cw = cnt + 64 * u.pm;
        if ((threadIdx.x & 63) == 0) __hip_atomic_fetch_add(cw, 1u, __ATOMIC_RELAXED, __HIP_MEMORY_SCOPE_AGENT);
        { unsigned sp = 0; while ((unsigned)__builtin_amdgcn_readfirstlane((int)__hip_atomic_load(cw, __ATOMIC_RELAXED, __HIP_MEMORY_SCOPE_AGENT)) < 64u) { __builtin_amdgcn_s_sleep(2); if (++sp > (1u << 22)) break; } }
        __builtin_amdgcn_fence(__ATOMIC_ACQUIRE, "agent");
#pragma unroll
        for (int ai = 0; ai < 2; ++ai)
#pragma unroll
            for (int m = 0; m < 4; ++m) { const int row = row0 + ai * HALF + m * 16; const size_t off = (size_t)row * DM + col0;
                const float rstd = rsqrtf(__hip_atomic_load(ss + row, __ATOMIC_RELAXED, __HIP_MEMORY_SCOPE_AGENT) * (1.f / DM) + EPS);
#pragma unroll
                for (int bj = 0; bj < 2; ++bj)
#pragma unroll
                    for (int n = 0; n < 2; ++n) { const int co = bj * HALF + n * 16; const f32x4 gv = *(const f32x4*)(gvec + col0 + co);
                        f32x4 o = acc[ai][bj][m][n] * rstd; o[0] *= gv[0]; o[1] *= gv[1]; o[2] *= gv[2]; o[3] *= gv[3];
                        *(f32x4*)(out + off + co) = o; } }
        return false;
    }
};
struct EpiUp {
    static constexpr bool PERM = true;
    const float* ss; bf16_t* hid;
    __device__ __forceinline__ bool operator()(f32x4 (&acc)[2][2][4][2], const Unit& u, int wr, int wc, int fr, int fq) const {
        const int row0 = u.pm * BM + wr * 64 + fr, col0 = u.pn * BM + wc * 32 + 8 * fq;
#pragma unroll
        for (int ai = 0; ai < 2; ++ai)
#pragma unroll
            for (int m = 0; m < 4; ++m) { const int row = row0 + ai * HALF + m * 16; const float rstd = rsqrtf(ss[row] * (1.f / DM) + EPS);
                bf16_t* rowp = hid + (size_t)row * DFF + col0;
#pragma unroll
                for (int bj = 0; bj < 2; ++bj) { f32x4 v0 = acc[ai][bj][m][0] * rstd, v1 = acc[ai][bj][m][1] * rstd;
#pragma unroll
                    for (int e = 0; e < 4; ++e) { const float a = fmaxf(v0[e], 0.f), b = fmaxf(v1[e], 0.f); v0[e] = a * a; v1[e] = b * b; }
                    u32x4 w; w.x = cvt_pk_bf16(v0[0], v0[1]); w.y = cvt_pk_bf16(v0[2], v0[3]); w.z = cvt_pk_bf16(v1[0], v1[1]); w.w = cvt_pk_bf16(v1[2], v1[3]);
                    *(u32x4*)(rowp + bj * HALF) = w; } }
        return false;
    }
};
}

namespace fox {
DI int ftid() { int t = threadIdx.x; asm volatile("" : "+v"(t)); return t; }
constexpr int D = 128, QS = DM, KS = DM, VS = DM, OS = DM;
constexpr float SCALE = 0.08838834764831845f, THR = 8.f;
constexpr int NW = 8, QBLK = 32, KVBLK = 64, QB = NW * QBLK;
constexpr int SHM_V = KVBLK * D * 2, SHM_K = KVBLK * D * 2;
constexpr int OFF_WS = 2 * SHM_V + 2 * SHM_K;
constexpr int OFF_BIAS = OFF_WS + NW * 64 * 4;
constexpr int BIAS_BYTES = LP * 4;
static_assert(OFF_BIAS + 2 * BIAS_BYTES <= RING_BYTES, "fox lds");
#define KSWZ(row, colB) ((row) * 256 + ((colB) ^ (((row) & 7) << 4)))
#define SBAR() __builtin_amdgcn_sched_barrier(0)
DI int v_st(int k, int c) { const int kk = (k & ~0xC) | ((k & 4) << 1) | ((k & 8) >> 1); return ((kk >> 3) * 4 + (c >> 5)) * 512 + ((kk & 7) * 32 + (c & 31)) * 2; }
DI int v_rd_base(int lane) { return ((lane & 3) << 3) | (((lane >> 2) & 3) << 6) | (((lane >> 4) & 1) << 5) | (((lane >> 5) & 1) << 8); }
constexpr int v_rd_off(int d0, int ks, int half) { return d0 * 512 + ks * 4096 + half * 2048; }
DI int crow(int r, int hi) { return (r & 3) + 8 * (r >> 2) + 4 * hi; }
DI bf16x8 load8(const bf16_t* p) { return *reinterpret_cast<const bf16x8*>(p); }
DI void mask_tile(f32x16& p0, f32x16& p1, int dq, unsigned W) {
    const float NEG = -__builtin_inff();
#pragma unroll
    for (int r = 0; r < 16; ++r) {
        const int c = (r & 3) + 8 * (r >> 2);
        if ((unsigned)(dq - c) >= W) p0[r] = NEG;
        if ((unsigned)(dq - c - 32) >= W) p1[r] = NEG;
    }
}
DI void partialSM(f32x16& p0, f32x16& p1, float& m_reg, float& mn, float& alpha) {
    float pmax = p0[0]; for (int r = 1; r < 16; ++r) pmax = fmaxf(pmax, p0[r]); for (int r = 0; r < 16; ++r) pmax = fmaxf(pmax, p1[r]);
    { auto rr = __builtin_amdgcn_permlane32_swap(__float_as_uint(pmax), __float_as_uint(pmax), false, false);
      pmax = fmaxf(__uint_as_float(rr[0]), __uint_as_float(rr[1])); }
    constexpr float C2 = 1.4426950408889634f * SCALE;
    if (__builtin_expect(__all((pmax - m_reg) * SCALE <= THR), 1)) { mn = m_reg; alpha = 1.f; }
    else { mn = fmaxf(m_reg, pmax); alpha = __builtin_amdgcn_exp2f((m_reg - mn) * C2); m_reg = mn; }
    const float mnL = -mn * C2;
    for (int r = 0; r < 16; ++r) p0[r] = fmaf(p0[r], C2, mnL); for (int r = 0; r < 16; ++r) p1[r] = fmaf(p1[r], C2, mnL);
    for (int r = 0; r < 16; ++r) p0[r] = __builtin_amdgcn_exp2f(p0[r]);
}
DI void finishSM(f32x16& p0, f32x16& p1, float alpha, float& l_reg, bf16x8& pa0, bf16x8& pa1, bf16x8& pa2, bf16x8& pa3) {
    for (int r = 0; r < 16; ++r) p1[r] = __builtin_amdgcn_exp2f(p1[r]);
    float ps = 0; for (int r = 0; r < 16; ++r) ps += p0[r]; for (int r = 0; r < 16; ++r) ps += p1[r];
    { auto rr = __builtin_amdgcn_permlane32_swap(__float_as_uint(ps), __float_as_uint(ps), false, false);
      ps = __uint_as_float(rr[0]) + __uint_as_float(rr[1]); }
    l_reg = l_reg * alpha + ps;
#define PK4(P, B_, OUT) do { unsigned a0 = cvt_pk_bf16(P[B_+0], P[B_+1]), a1 = cvt_pk_bf16(P[B_+2], P[B_+3]);                          \
        unsigned b0 = cvt_pk_bf16(P[B_+4], P[B_+5]), b1 = cvt_pk_bf16(P[B_+6], P[B_+7]);                                             \
        auto r0 = __builtin_amdgcn_permlane32_swap(a0, b0, false, false); auto r1 = __builtin_amdgcn_permlane32_swap(a1, b1, false, false); \
        u32x4 w = {r0[0], r1[0], r0[1], r1[1]}; OUT = *reinterpret_cast<bf16x8*>(&w); } while (0)
    PK4(p0, 0, pa0); PK4(p0, 8, pa1); PK4(p1, 0, pa2); PK4(p1, 8, pa3);
#undef PK4
}
template <int KB>
DI void qkt(f32x16& p0, f32x16& p1, const char* K_lds, const char* bias_t, int r32_in, int hi_in, const bf16x8* qr) {
    int l_ = threadIdx.x; asm volatile("" : "+v"(l_)); const int r32 = l_ & 31, hi = (l_ >> 5) & 1;
    { const char* bp = bias_t + 16 * hi;
#pragma unroll
      for (int gq = 0; gq < 4; ++gq) { const f32x4 a = *(const f32x4*)(bp + 32 * gq); const f32x4 b = *(const f32x4*)(bp + 128 + 32 * gq);
          p0[4 * gq] = a[0]; p0[4 * gq + 1] = a[1]; p0[4 * gq + 2] = a[2]; p0[4 * gq + 3] = a[3];
          p1[4 * gq] = b[0]; p1[4 * gq + 1] = b[1]; p1[4 * gq + 2] = b[2]; p1[4 * gq + 3] = b[3]; } }
    const char* kb[4];
#pragma unroll
    for (int dd = 0; dd < 4; ++dd) kb[dd] = K_lds + KB * SHM_K + KSWZ(r32, (dd * 16 + hi * 8) * 2);
#pragma unroll
    for (int d0 = 0; d0 < 8; ++d0) { const char* a = kb[d0 & 3] + (d0 >> 2) * 128;
        bf16x8 b0 = *reinterpret_cast<const bf16x8*>(a);
        bf16x8 b1 = *reinterpret_cast<const bf16x8*>(a + 32 * 256);
        p0 = __builtin_amdgcn_mfma_f32_32x32x16_bf16(b0, qr[d0], p0, 0, 0, 0);
        p1 = __builtin_amdgcn_mfma_f32_32x32x16_bf16(b1, qr[d0], p1, 0, 0, 0); }
}
template <int VB>
DI void pv_tile(f32x16* o, int vb0, bf16x8 pa0, bf16x8 pa1, bf16x8 pa2, bf16x8 pa3) {
#define TRRD(dst, off) asm volatile("ds_read_b64_tr_b16 %0, %1 offset:%2" : "=&v"(dst) : "v"(vb0), "i"(off) : "memory")
#define PV_D0(d0) do { s16x4 l0, l1, l2, l3, h0, h1, h2, h3; constexpr int b_ = VB * SHM_V + v_rd_off(d0, 0, 0); \
        TRRD(l0, b_); TRRD(h0, b_ + 2048); TRRD(l1, b_ + 4096); TRRD(h1, b_ + 6144); TRRD(l2, b_ + 8192); TRRD(h2, b_ + 10240); TRRD(l3, b_ + 12288); TRRD(h3, b_ + 14336); \
        asm volatile("s_waitcnt lgkmcnt(0)" ::: "memory"); SBAR();   \
        o[d0] = __builtin_amdgcn_mfma_f32_32x32x16_bf16(pa0, (bf16x8){l0[0], l0[1], l0[2], l0[3], h0[0], h0[1], h0[2], h0[3]}, o[d0], 0, 0, 0);   \
        o[d0] = __builtin_amdgcn_mfma_f32_32x32x16_bf16(pa1, (bf16x8){l1[0], l1[1], l1[2], l1[3], h1[0], h1[1], h1[2], h1[3]}, o[d0], 0, 0, 0);   \
        o[d0] = __builtin_amdgcn_mfma_f32_32x32x16_bf16(pa2, (bf16x8){l2[0], l2[1], l2[2], l2[3], h2[0], h2[1], h2[2], h2[3]}, o[d0], 0, 0, 0);   \
        o[d0] = __builtin_amdgcn_mfma_f32_32x32x16_bf16(pa3, (bf16x8){l3[0], l3[1], l3[2], l3[3], h3[0], h3[1], h3[2], h3[3]}, o[d0], 0, 0, 0); } while (0)
    PV_D0(0); PV_D0(1); PV_D0(2); PV_D0(3);
#undef PV_D0
#undef TRRD
}
struct BlockRef { const bf16_t* Q; const bf16_t* K; const bf16_t* V; bf16_t* O; const float* bias; int P0; };
struct Seam { bf16x8 qr[8]; bf16x8 st_v0, st_v1, st_k0, st_k1; };
#define LAUNDER(v) asm volatile("" : "+v"(v))
#define VMW() asm volatile("s_waitcnt vmcnt(0)" ::: "memory")
#define SLOAD_H(Kp, Vp, k0) do { int t_ = threadIdx.x; LAUNDER(t_); const int sr_ = t_ >> 4, sc_ = (t_ & 15) * 8;                   \
        const bf16_t* kp_ = (Kp) + (size_t)(k0) * KS; const bf16_t* vp_ = (Vp) + (size_t)(k0) * VS;                                 \
        const unsigned ok_ = (unsigned)(sr_ * KS + sc_), ov_ = (unsigned)(sr_ * VS + sc_);                                          \
        S.st_v0 = load8(vp_ + ov_); S.st_v1 = load8(vp_ + ov_ + 32 * VS); S.st_k0 = load8(kp_ + ok_); S.st_k1 = load8(kp_ + ok_ + 32 * KS); } while (0)
#define SWRITE_HK(bf) do { int t_ = threadIdx.x; LAUNDER(t_); const int sr_ = t_ >> 4, sc_ = (t_ & 15) * 8, kws_ = KSWZ(sr_, sc_ * 2);     \
        *(bf16x8*)(K_lds + (bf) * SHM_K + kws_) = S.st_k0; *(bf16x8*)(K_lds + (bf) * SHM_K + kws_ + 32 * 256) = S.st_k1; } while (0)
#define SWRITE_HV(bf) do { int t_ = threadIdx.x; LAUNDER(t_); const int sr_ = t_ >> 4, sc_ = (t_ & 15) * 8;                               \
        *(bf16x8*)(V_lds + (bf) * SHM_V + v_st(sr_, sc_)) = S.st_v0; *(bf16x8*)(V_lds + (bf) * SHM_V + v_st(32 + sr_, sc_)) = S.st_v1; } while (0)
#define SWRITE_H(bf) do { SWRITE_HV(bf); SWRITE_HK(bf); } while (0)
DI void bias_stage(const float* bias, char* lds, int par) {
    const int tid = ftid(), wid = __builtin_amdgcn_readfirstlane(tid >> 6);
    LAS unsigned char* dst = (LAS unsigned char*)lds + OFF_BIAS + par * BIAS_BYTES + wid * 1024;
    __builtin_amdgcn_global_load_lds((const unsigned*)(bias + tid * 4), (LAS unsigned*)dst, 16, 0, 0);
    __builtin_amdgcn_global_load_lds((const unsigned*)(bias + 2048 + tid * 4), (LAS unsigned*)(dst + 8192), 16, 0, 0);
    if (tid < 16) __builtin_amdgcn_global_load_lds((const unsigned*)(bias + 4096 + tid * 4), (LAS unsigned*)(dst + 16384), 16, 0, 0);
}
DI void causal_prime(const BlockRef& cur, char* lds, Seam& S, int par) {
    const int tid = ftid(), wid = __builtin_amdgcn_readfirstlane(tid >> 6), lane = tid & 63, r32 = lane & 31, hi = lane >> 5;
    char* K_lds = lds + 2 * SHM_V;
    bias_stage(cur.bias, lds, par);
    for (int d0 = 0; d0 < 8; ++d0) S.qr[d0] = load8(cur.Q + (unsigned)((wid * QBLK + r32) * QS + d0 * 16 + hi * 8));
    SLOAD_H(cur.K, cur.V, 0); VMW(); SWRITE_HK(0);
    __syncthreads();
}
DI void causal_block(const BlockRef& cur, const BlockRef& nxt, char* lds, Seam& S, int par) {
    const int tid = ftid(), wid = __builtin_amdgcn_readfirstlane(tid >> 6), lane = tid & 63, r32 = lane & 31, hi = lane >> 5;
    constexpr unsigned W = 1u << 30;
    const int NT = (cur.P0 + QB - 1) / KVBLK + 1;
    const int qlo = cur.P0 + wid * QBLK, qm = qlo + r32 - 4 * hi;
    char* V_lds = lds; char* K_lds = lds + 2 * SHM_V;
    float* ws = (float*)(lds + OFF_WS) + wid * 64; float* li_l = ws, * al_l = ws + 32;
    const char* bias_l = lds + OFF_BIAS + par * BIAS_BYTES;
    float m_reg = -1e30f, l_reg = 0; f32x16 o[4] = {};
    const int vb0 = (int)(uintptr_t)V_lds + v_rd_base(lane);
    const bf16_t* Kh = cur.K; const bf16_t* Vh = cur.V;
#define RESC(a) do { if (__any((a) < 1.f)) { if (hi == 0) al_l[r32] = (a); asm volatile("s_waitcnt lgkmcnt(0)" ::: "memory");              \
                     for (int d_ = 0; d_ < 4; ++d_) for (int r = 0; r < 16; ++r) o[d_][r] *= al_l[crow(r, hi)]; } } while (0)
#define KBASE(t) ((t) * KVBLK)
#define MASKT(P0_, P1_, t) do { const int kb_ = KBASE(t); if (kb_ + KVBLK - 1 > qlo) mask_tile(P0_, P1_, qm - kb_, W); } while (0)
#define BIAST(t) (bias_l + (t) * (KVBLK * 4))
    f32x16 pA0, pA1, pB0, pB1; float mnA, mnB, alA, alB; bf16x8 pa0, pa1, pa2, pa3;
    SWRITE_HV(0); SBAR();
    if (NT > 1) { SLOAD_H(Kh, Vh, KBASE(1)); }
    SBAR(); qkt<0>(pA0, pA1, K_lds, BIAST(0), r32, hi, S.qr);
    MASKT(pA0, pA1, 0); partialSM(pA0, pA1, m_reg, mnA, alA);
    if (NT > 1) { VMW(); SWRITE_H(1); }
    __syncthreads();
#define HALF_STEP(PX0, PX1, mnX, alX, PY0, PY1, alY, t, KB, VB, SB) do {                                                      \
        SBAR(); qkt<KB>(PX0, PX1, K_lds, BIAST(t), r32, hi, S.qr);                                             \
        finishSM(PY0, PY1, alY, l_reg, pa0, pa1, pa2, pa3); SBAR();                                                           \
        if ((t) + 1 < NT) { SLOAD_H(Kh, Vh, KBASE((t) + 1)); SBAR(); }                                               \
        pv_tile<VB>(o, vb0, pa0, pa1, pa2, pa3); MASKT(PX0, PX1, (t)); partialSM(PX0, PX1, m_reg, mnX, alX);                                        \
        __syncthreads();                                                                                                      \
        if ((t) + 1 < NT) { VMW(); SWRITE_H(SB); }                                                                          \
        RESC(alX); __syncthreads(); } while (0)
    for (int t = 1; t + 1 < NT; t += 2) {
        HALF_STEP(pB0, pB1, mnB, alB, pA0, pA1, alA, t, 1, 0, 0);
        HALF_STEP(pA0, pA1, mnA, alA, pB0, pB1, alB, t + 1, 0, 1, 1);
    }
    const bool even = (NT & 1) == 0;
    if (even) { SBAR(); qkt<1>(pB0, pB1, K_lds, BIAST(NT - 1), r32, hi, S.qr); SBAR(); }
    bias_stage(nxt.bias, lds, par ^ 1); SBAR();
    SLOAD_H(nxt.K, nxt.V, 0); SBAR();
#pragma unroll
    for (int d0 = 0; d0 < 8; ++d0) S.qr[d0] = load8(nxt.Q + (unsigned)((wid * QBLK + r32) * QS + d0 * 16 + hi * 8));
    SBAR();
    finishSM(pA0, pA1, alA, l_reg, pa0, pa1, pa2, pa3); SBAR();
    pv_tile<0>(o, vb0, pa0, pa1, pa2, pa3);
    if (even) { MASKT(pB0, pB1, NT - 1); partialSM(pB0, pB1, m_reg, mnB, alB); __syncthreads(); RESC(alB);
        finishSM(pB0, pB1, alB, l_reg, pa0, pa1, pa2, pa3); SBAR(); pv_tile<1>(o, vb0, pa0, pa1, pa2, pa3); }
    SBAR(); VMW(); SWRITE_HK(0); SBAR();
    if (hi == 0) li_l[r32] = l_reg; asm volatile("s_waitcnt lgkmcnt(0)" ::: "memory");
    float rli[16];
#pragma unroll
    for (int r = 0; r < 16; ++r) rli[r] = __builtin_amdgcn_rcpf(li_l[crow(r, hi)]);
    bf16_t* Ow = cur.O + (unsigned)(wid * QBLK * OS + r32);
#pragma unroll
    for (int r = 0; r < 16; ++r) { const int orow = crow(r, hi);
#pragma unroll
        for (int d0 = 0; d0 < 4; ++d0) { const float v = o[d0][r] * rli[r];
            const float vn = __shfl_xor(v, 1);
            if ((r32 & 1) == 0) *(unsigned*)(Ow + (unsigned)(orow * OS + d0 * 32)) = cvt_pk_bf16(v, vn); } }
    __syncthreads();
#undef RESC
#undef KBASE
#undef MASKT
#undef BIAST
#undef HALF_STEP
}
#undef LAUNDER
#undef VMW
#undef SLOAD_H
#undef SWRITE_HK
#undef SWRITE_HV
#undef SWRITE_H
#undef SBAR
#undef KSWZ
}

struct Args {
    const float *x, *meta, *mix_g, *w_in, *conv_w, *a_log, *dt_bias, *gdn_g, *w_o_gdn, *fox_qg, *fox_kg, *fox_fb, *w_o_fox, *w_out, *mlp_g, *w_up, *w_down, *final_g;
    float* out; unsigned char* ws;
};

DI void p0_transpose_item(const float* W, int K, int ldw, int src_c0, bf16_t* WT, int dst_r0, LAS float* scr, int kb, int nb, int lane) {
    const int k0 = 64 * kb, n0 = 32 * nb;
    const float* src = W + (size_t)(k0 + (lane >> 3)) * ldw + src_c0 + n0 + (lane & 7) * 4;
    f32x4 v[8];
#pragma unroll
    for (int i = 0; i < 8; ++i) v[i] = *(const f32x4*)(src + (size_t)(8 * i) * ldw);
#pragma unroll
    for (int i = 0; i < 8; ++i) { LAS float* d = scr + (8 * i + (lane >> 3)) * 33 + (lane & 7) * 4; d[0] = v[i][0]; d[1] = v[i][1]; d[2] = v[i][2]; d[3] = v[i][3]; }
    asm volatile("s_waitcnt lgkmcnt(0)" ::: "memory");
    const int c = lane & 7;
#pragma unroll
    for (int j = 0; j < 4; ++j) { const int n = (lane >> 3) + 8 * j; const LAS float* s = scr + (8 * c) * 33 + n;
        u32x4 o; o.x = cvt_pk_bf16(s[0 * 33], s[1 * 33]); o.y = cvt_pk_bf16(s[2 * 33], s[3 * 33]); o.z = cvt_pk_bf16(s[4 * 33], s[5 * 33]); o.w = cvt_pk_bf16(s[6 * 33], s[7 * 33]);
        *(u32x4*)(WT + (size_t)(dst_r0 + n0 + n) * K + k0 + 8 * c) = o; }
    asm volatile("s_waitcnt lgkmcnt(0)" ::: "memory");
}
DI void rms_row_to_bf16(const float* xrow, const float* g, bf16_t* orow, int lane) {
    const f32x4* xr = (const f32x4*)xrow + lane; const f32x4* gr = (const f32x4*)g + lane;
    f32x4 v[8]; float s = 0.f;
#pragma unroll
    for (int j = 0; j < 8; ++j) { v[j] = xr[64 * j]; s += (v[j].x * v[j].x + v[j].y * v[j].y) + (v[j].z * v[j].z + v[j].w * v[j].w); }
    const float rstd = rsqrtf(wave_sum(s) * (1.f / DM) + EPS);
    u32x2* o8 = (u32x2*)orow + lane;
#pragma unroll
    for (int j = 0; j < 8; ++j) { const f32x4 gg = gr[64 * j]; u32x2 w; w.x = cvt_pk_bf16(v[j].x * rstd * gg.x, v[j].y * rstd * gg.y); w.y = cvt_pk_bf16(v[j].z * rstd * gg.z, v[j].w * rstd * gg.w); o8[64 * j] = w; }
}
DI float log_sigmoid_(float x) { return fminf(x, 0.f) - log1pf(__expf(-fabsf(x))); }
DI float softplus_(float x) { return fmaxf(x, 0.f) + log1pf(__expf(-fabsf(x))); }
DI bf16x8 ld2x8(const bf16_t* p) { const s16x4 lo = *(const s16x4*)p; const s16x4 hi = *(const s16x4*)(p + 16); return __builtin_shufflevector(lo, hi, 0, 1, 2, 3, 4, 5, 6, 7); }
DI bf16x8 packacc(const f32x4 a, const f32x4 b) { u32x4 w = {cvt_pk_bf16(a[0], a[1]), cvt_pk_bf16(a[2], a[3]), cvt_pk_bf16(b[0], b[1]), cvt_pk_bf16(b[2], b[3])}; return __builtin_bit_cast(bf16x8, w); }
#define MFMA16(a, b, c) __builtin_amdgcn_mfma_f32_16x16x32_bf16((a), (b), (c), 0, 0, 0)
#define MFMA32(a, b, c) __builtin_amdgcn_mfma_f32_32x32x16_bf16((a), (b), (c), 0, 0, 0)

DI void glds16(const void* gsrc, unsigned lds_dst) { unsigned keep;
    asm volatile("s_mov_b32 %0, m0\n\ts_mov_b32 m0, %2\n\ts_nop 0\n\tglobal_load_lds_dwordx4 %1, off\n\ts_mov_b32 m0, %0" : "=&s"(keep) : "v"(gsrc), "s"(lds_dst) : "memory"); }

#define XB_TMO      128
#define XB_XCNT(j)  (256  + 64 * (j))
#define XB_XSUB(j)  (1280 + 64 * (j))
#define XB_XGEN(j)  (2304 + 64 * (j))
#define XB_TOP      3328
#define XB_TOPGEN   3392
#define XCD_BAR_WORDS 3456
#define XB_SPIN_CAP (1u << 18)
DI unsigned xb_ld(unsigned* p)              { return __hip_atomic_load(p, __ATOMIC_RELAXED, __HIP_MEMORY_SCOPE_AGENT); }
DI unsigned xb_add(unsigned* p, unsigned v) { return __hip_atomic_fetch_add(p, v, __ATOMIC_RELAXED, __HIP_MEMORY_SCOPE_AGENT); }
DI unsigned xb_xcc_id() { return (unsigned)__builtin_amdgcn_s_getreg((3 << 11) | 20) & 0xFu; }
#define XB_SPIN(cond, bar) do { unsigned _sp = 0; while (cond) { __builtin_amdgcn_s_sleep(1); \
    if ((++_sp & 255u) == 0u) { if (xb_ld(&(bar)[XB_TMO])) break; if (_sp > XB_SPIN_CAP) { atomicAdd(&(bar)[XB_TMO], 1u); break; } } } } while (0)
struct XcdBarrier { unsigned* bar; unsigned x; volatile LAS unsigned* st; };
DI XcdBarrier xcd_barrier_post(unsigned* bar, volatile LAS unsigned* st) {
    XcdBarrier b; b.bar = bar; b.x = xb_xcc_id(); b.st = st;
    if (threadIdx.x == 0) (void)xb_add(&bar[XB_XCNT(b.x)], 1u);
    return b;
}
DI void xcd_barrier_complete(unsigned* bar, unsigned x, unsigned& nloc, unsigned& nx) {
    const unsigned G = gridDim.x * gridDim.y * gridDim.z;
    unsigned sum, cnt, mine, sp = 0u;
    for (;;) {
        sum = 0u; cnt = 0u; mine = 0u;
#pragma unroll
        for (unsigned j = 0; j < 16; ++j) { const unsigned c = xb_ld(&bar[XB_XCNT(j)]); sum += c; cnt += (c > 0u) ? 1u : 0u; mine = (j == x) ? c : mine; }
        if (sum == G) break;
        __builtin_amdgcn_s_sleep(1);
        if ((++sp & 255u) == 0u) { if (xb_ld(&bar[XB_TMO])) break; if (sp > XB_SPIN_CAP) { atomicAdd(&bar[XB_TMO], 1u); break; } }
    }
    nloc = mine > 0u ? mine : 1u; nx = cnt > 0u ? cnt : 1u;
}
DI void xcd_barrier(const XcdBarrier& b) {
    asm volatile("s_waitcnt vmcnt(0)" ::: "memory");
    __syncthreads();
    if (threadIdx.x == 0) {
        unsigned* bar = b.bar;
        __builtin_amdgcn_s_waitcnt(0);
        unsigned nloc = b.st[0], nx = b.st[1];
        if (nloc == 0u) { xcd_barrier_complete(bar, b.x, nloc, nx); b.st[0] = nloc; b.st[1] = nx; }
        const unsigned old = xb_add(&bar[XB_XSUB(b.x)], 1u);
        const unsigned gen = old / nloc;
        if (old + 1u == (gen + 1u) * nloc) {
            __builtin_amdgcn_fence(__ATOMIC_RELEASE, "agent");
            asm volatile("s_waitcnt vmcnt(0)" ::: "memory");
            const unsigned og = xb_add(&bar[XB_TOP], 1u);
            const unsigned tg = og / nx;
            if (og + 1u == (tg + 1u) * nx) xb_add(&bar[XB_TOPGEN], 1u);
            else XB_SPIN(xb_ld(&bar[XB_TOPGEN]) == tg, bar);
            __builtin_amdgcn_fence(__ATOMIC_ACQUIRE, "agent");
            xb_add(&bar[XB_XGEN(b.x)], 1u);
            asm volatile("s_waitcnt vmcnt(0)" ::: "memory");
        } else {
            XB_SPIN(xb_ld(&bar[XB_XGEN(b.x)]) == gen, bar);
            __builtin_amdgcn_fence(__ATOMIC_ACQUIRE, "agent");
            asm volatile("s_waitcnt vmcnt(0)" ::: "memory");
        }
    }
    __syncthreads();
}
typedef const __attribute__((address_space(4))) Args CArgs;
#define PH_BEGIN \
    CArgs* ap = (CArgs*)__builtin_amdgcn_kernarg_segment_ptr(); asm volatile("" : "+s"(ap)); \
    int tid = threadIdx.x; asm volatile("" : "+v"(tid)); \
    const int lane = tid & 63, wave = __builtin_amdgcn_readfirstlane(tid >> 6); \
    const int G = gridDim.x, bx = blockIdx.x, gw = bx * 8 + wave, NGW = G * 8; \
    unsigned char* ws = ap->ws; LAS unsigned char* ldsl = (LAS unsigned char*)lds; \
    (void)lane; (void)wave; (void)gw; (void)NGW; (void)ws; (void)ldsl;
#define WSP(T, off) ((T*)(ws + (off)))

__global__ void __launch_bounds__(512) mk_fwd(Args args_unused) {
    extern __shared__ __attribute__((aligned(16))) unsigned char lds[];
    cg::grid_group grid = cg::this_grid();
    if (threadIdx.x < 64) ((LAS unsigned*)((LAS unsigned char*)lds + MISC_OFF))[threadIdx.x] = 0u;
    __syncthreads();
    const XcdBarrier xbar = xcd_barrier_post((unsigned*)(((CArgs*)__builtin_amdgcn_kernarg_segment_ptr())->ws + O_CTL) + CW_BAR, (volatile LAS unsigned*)((LAS unsigned char*)lds + MISC_OFF) + 8);
    {
        PH_BEGIN
        bf16_t* WTIN = WSP(bf16_t, O_WTIN); bf16_t* U = WSP(bf16_t, O_U); bf16_t* WOG = WSP(bf16_t, O_WOG); bf16_t* WOF = WSP(bf16_t, O_WOF); bf16_t* WOUT = WSP(bf16_t, O_WOUT); bf16_t* WUP = WSP(bf16_t, O_WUP); bf16_t* WDN = WSP(bf16_t, O_WDN);
        LAS float* scr = (LAS float*)(ldsl + wave * 16384);
        constexpr int I_IN = 32 * (NBIG / 32);
        for (int it = gw; it < I_IN; it += NGW) {
            const int nbk = NBIG / 32, kb = it / nbk, nb = it % nbk; const int dr = nb * 32; int sc;
            if (dr < 6144) sc = dr; else if (dr < 8192) sc = dr; else if (dr < 14336) sc = dr - 8192 + 8224; else if (dr < 16384) sc = dr - 14336 + 14384; else sc = dr - 16384 + 16432;
            p0_transpose_item(ap->w_in, DM, NIN, sc, WTIN, dr, scr, kb, 0, lane);
        }
        for (int e = bx * 512 + tid; e < 64 * DM; e += G * 512) { const int j = e / DM, k = e % DM; float v = 0.f;
            if (j < 48) { const int sc = j < 16 ? 8192 + j : (j < 32 ? 8208 + (j - 16) : 14368 + (j - 32)); v = ap->w_in[(size_t)k * NIN + sc]; }
            WTIN[(size_t)(NBIG + j) * DM + k] = f2bf(v); }
        for (int m = gw; m < MX + NMETA; m += NGW) rms_row_to_bf16(m < MX ? ap->x + (size_t)m * DM : ap->meta + (size_t)(m - MX) * DM, ap->mix_g, U + (size_t)m * DM, lane);
    }
    grid.sync();

    {
        PH_BEGIN
        bf16_t* WTIN = WSP(bf16_t, O_WTIN); bf16_t* U = WSP(bf16_t, O_U); bf16_t* GRAW = WSP(bf16_t, O_GRAW); bf16_t* FQN = WSP(bf16_t, O_FQN); bf16_t* FKN = WSP(bf16_t, O_FKN); bf16_t* FVN = WSP(bf16_t, O_FVN); bf16_t* Z = WSP(bf16_t, O_Z); bf16_t* GA = WSP(bf16_t, O_GA); bf16_t* GB = WSP(bf16_t, O_GB); float* SM = WSP(float, O_SM);
        pg8::Gemm g{U, WTIN, MX, NBIG, DM, 1 << 30, 0}; pg8::StaticOrder S; S.init(MX, NBIG, G, bx);
        pg8::EpiIn E{GRAW, Z, FQN, FKN, FVN, GA, GB, ap->fox_qg, ap->fox_kg, (LAS float*)(ldsl + RING_BYTES)};
        pg8::gemm_phase<pg8::EpiIn, pg8::StaticOrder>(ldsl, g, S, E);
        const int m16 = lane & 15, g4 = lane >> 4;
        constexpr int T_META = 384 + 384 + 3, T_SMALL = MX / 16;
        const int gwm = wave * G + bx;
        for (int t = gwm; t < T_META + T_SMALL; t += NGW) {
            if (t < T_META) {
                int wrow, dcol; int kind;
                if (t < 384) { wrow = 16 * t; dcol = 16 * t; kind = 0; } else if (t < 768) { wrow = 8192 + 16 * (t - 384); dcol = 16 * (t - 384); kind = 1; } else { wrow = NBIG + 16 * (t - 768); dcol = 16 * (t - 768); kind = 2; }
                const bf16_t* ap = U + (size_t)(MX + m16) * DM + 8 * g4; const bf16_t* bp = WTIN + (size_t)(wrow + m16) * DM + 8 * g4;
                f32x4 acc = {0.f, 0.f, 0.f, 0.f};
                f32x4 accb = {0.f, 0.f, 0.f, 0.f};
#pragma unroll 8
                for (int kk = 0; kk < DM / 32; kk += 2) { acc = MFMA16(*(const bf16x8*)(ap + 32 * kk), *(const bf16x8*)(bp + 32 * kk), acc);
                    accb = MFMA16(*(const bf16x8*)(ap + 32 * kk + 32), *(const bf16x8*)(bp + 32 * kk + 32), accb); }
                acc += accb;
#pragma unroll
                for (int r = 0; r < 4; ++r) { const int mt = 4 * g4 + r;
#pragma unroll
                    for (int b = 0; b < NB; ++b) { const size_t rp = (size_t)b * LP + PADF + mt;
                        if (kind == 0) GRAW[rp * 6144 + dcol + m16] = f2bf(acc[r]); else if (kind == 1) { if (dcol >= 4096) FVN[rp * DM + dcol - 4096 + m16] = f2bf(acc[r]); else if (dcol >= 2048) FKN[rp * DM + dcol - 2048 + m16] = f2bf(acc[r]);   } else SM[rp * NSM + dcol + m16] = acc[r]; } }
            } else {
                const int rt = t - T_META;
                const bf16_t* ap = U + (size_t)(16 * rt + m16) * DM + 8 * g4; const bf16_t* bp = WTIN + (size_t)(NBIG + m16) * DM + 8 * g4;
                f32x4 a0 = {0.f, 0.f, 0.f, 0.f}, a1 = a0, a2 = a0;
#pragma unroll 8
                for (int kk = 0; kk < DM / 32; ++kk) { const bf16x8 av = *(const bf16x8*)(ap + 32 * kk);
                    a0 = MFMA16(av, *(const bf16x8*)(bp + 32 * kk), a0); a1 = MFMA16(av, *(const bf16x8*)(bp + 16 * DM + 32 * kk), a1); a2 = MFMA16(av, *(const bf16x8*)(bp + 32 * DM + 32 * kk), a2); }
#pragma unroll
                for (int r = 0; r < 4; ++r) { const int m = 16 * rt + 4 * g4 + r; const size_t rp = (size_t)m + XOFF + 64 * (m >> 12);
                    SM[rp * NSM + m16] = a0[r]; SM[rp * NSM + 16 + m16] = a1[r]; SM[rp * NSM + 32 + m16] = a2[r]; }
            }
        }
    }
    xcd_barrier(xbar);

    {
        PH_BEGIN
        bf16_t* GRAW = WSP(bf16_t, O_GRAW); bf16_t* FVN = WSP(bf16_t, O_FVN); bf16_t* GQN = WSP(bf16_t, O_GQN); bf16_t* GKN = WSP(bf16_t, O_GKN); bf16_t* GVN = WSP(bf16_t, O_GVN); bf16_t* FQN = WSP(bf16_t, O_FQN); bf16_t* FKN = WSP(bf16_t, O_FKN);
        float* SM = WSP(float, O_SM); float* BETA = WSP(float, O_BETA); float* GG = WSP(float, O_GG); float* FB = WSP(float, O_FB);
        const float QSC = 0.08838834764831845f;
#define LDROW(tp_) (((tp_) >= PADF) ? *(const u32x4*)(src + (size_t)(tp_) * 6144) : (u32x4){0u, 0u, 0u, 0u})
#define UNPK(dstf, u) do { dstf[0] = __uint_as_float(u.x << 16); dstf[1] = __uint_as_float(u.x & 0xffff0000u); dstf[2] = __uint_as_float(u.y << 16); dstf[3] = __uint_as_float(u.y & 0xffff0000u); \
                           dstf[4] = __uint_as_float(u.z << 16); dstf[5] = __uint_as_float(u.z & 0xffff0000u); dstf[6] = __uint_as_float(u.w << 16); dstf[7] = __uint_as_float(u.w & 0xffff0000u); } while (0)
        for (int it = gw; it < 640 * 12; it += NGW) {
            const int strip = it / 12, cgp = it % 12; const int b = strip / 320, tp0 = (strip % 320) * 13;
            const int ch0 = cgp * 512 + lane * 8;
            float cw[4][8];
#pragma unroll
            for (int k = 0; k < 4; ++k) { const f32x4 a = *(const f32x4*)(ap->conv_w + k * 6144 + ch0), c = *(const f32x4*)(ap->conv_w + k * 6144 + ch0 + 4);
                cw[k][0] = a[0]; cw[k][1] = a[1]; cw[k][2] = a[2]; cw[k][3] = a[3]; cw[k][4] = c[0]; cw[k][5] = c[1]; cw[k][6] = c[2]; cw[k][7] = c[3]; }
            const bf16_t* src = GRAW + (size_t)b * LP * 6144 + ch0;
            bf16_t* dst = (cgp < 4 ? GQN : (cgp < 8 ? GKN : GVN)) + (size_t)b * LP * DM + (cgp & 3) * 512 + lane * 8;
            u32x4 ur[16];
#pragma unroll
            for (int i = 0; i < 16; ++i) ur[i] = LDROW(tp0 - 3 + i);
            float x0[8], x1[8], x2[8];
            UNPK(x0, ur[0]); UNPK(x1, ur[1]); UNPK(x2, ur[2]);
#pragma unroll
            for (int i = 0; i < 13; ++i) { const int tp = tp0 + i; float x3[8], y[8]; UNPK(x3, ur[3 + i]); float ssq = 0.f;
#pragma unroll
                for (int e = 0; e < 8; ++e) { const float c = cw[0][e] * x0[e] + cw[1][e] * x1[e] + cw[2][e] * x2[e] + cw[3][e] * x3[e]; y[e] = c * __builtin_amdgcn_rcpf(1.f + __expf(-c)); ssq += y[e] * y[e]; }
                if (cgp < 8) { ssq = sum16(ssq);
                    const float sc = rsqrtf(ssq + EPS) * (cgp < 4 ? QSC : 1.f);
#pragma unroll
                    for (int e = 0; e < 8; ++e) y[e] *= sc; }
                u32x4 w; w.x = cvt_pk_bf16(y[0], y[1]); w.y = cvt_pk_bf16(y[2], y[3]); w.z = cvt_pk_bf16(y[4], y[5]); w.w = cvt_pk_bf16(y[6], y[7]);
                *(u32x4*)(dst + (size_t)tp * DM) = w;
#pragma unroll
                for (int e = 0; e < 8; ++e) { x0[e] = x1[e]; x1[e] = x2[e]; x2[e] = x3[e]; } }
        }
        for (int it = gw; it < NB * XOFF; it += NGW) {
            const int b = it / XOFF, tp = it % XOFF; const size_t rp = (size_t)b * LP + tp;
            bf16_t* kd = FKN + rp * DM + lane * 32;
            if (tp < PADF) { bf16_t* vd = FVN + rp * DM + lane * 32;
#pragma unroll
                for (int i = 0; i < 4; ++i) { *(u32x4*)(kd + 8 * i) = (u32x4){0u, 0u, 0u, 0u}; *(u32x4*)(vd + 8 * i) = (u32x4){0u, 0u, 0u, 0u}; }
                continue; }
            const float* gp = ap->fox_kg + (lane & 3) * 32;
            float v[32]; float ssq = 0.f;
#pragma unroll
            for (int i = 0; i < 4; ++i) { const u32x4 u = *(const u32x4*)(kd + 8 * i); float f[8]; UNPK(f, u);
#pragma unroll
                for (int e = 0; e < 8; ++e) { v[8 * i + e] = f[e]; ssq += f[e] * f[e]; } }
            ssq = sum4(ssq);
            const float rstd = rsqrtf(ssq * (1.f / DH) + EPS);
#pragma unroll
            for (int i = 0; i < 4; ++i) { const f32x4 g0 = *(const f32x4*)(gp + 8 * i), g1 = *(const f32x4*)(gp + 8 * i + 4); u32x4 w;
                w.x = cvt_pk_bf16(v[8 * i] * rstd * g0[0], v[8 * i + 1] * rstd * g0[1]); w.y = cvt_pk_bf16(v[8 * i + 2] * rstd * g0[2], v[8 * i + 3] * rstd * g0[3]);
                w.z = cvt_pk_bf16(v[8 * i + 4] * rstd * g1[0], v[8 * i + 5] * rstd * g1[1]); w.w = cvt_pk_bf16(v[8 * i + 6] * rstd * g1[2], v[8 * i + 7] * rstd * g1[3]);
                *(u32x4*)(kd + 8 * i) = w; }
        }
#undef LDROW
#undef UNPK
        for (int e = bx * 512 + tid; e < NB * NH * LP; e += G * 512) {
            const int bh = e / LP, tp = e % LP, b = bh >> 4, h = bh & 15; float be = 0.f, gg = 0.f;
            if (tp >= PADF) { const float* sm = SM + ((size_t)b * LP + tp) * NSM; be = sigmoidf_(sm[h]); gg = -__expf(ap->a_log[h]) * softplus_(sm[16 + h] + ap->dt_bias[h]); }
            BETA[e] = be; GG[e] = gg; }
        { const int gwm = (NGW == 2048) ? ((gw >= 1536 && ((gw - 1536) & 15) == 0) ? ((gw - 1536) >> 4) : (1 << 20)) : (wave * G + bx);
          for (int bh = gwm; bh < NB * NH; bh += NGW) { const int b = bh >> 4, h = bh & 15; const float fbias = ap->fox_fb[h]; float carry = 0.f;
            float fv[NCH];
#pragma unroll
            for (int i = 0; i < NCH; ++i) { const int tp = i * 64 + lane; fv[i] = (tp >= PADF) ? SM[((size_t)b * LP + tp) * NSM + 32 + h] : 0.f; }
#pragma unroll
            for (int i = 0; i < NCH; ++i) { const int tp = i * 64 + lane; float v = (tp >= PADF) ? log_sigmoid_(fv[i] + fbias) : 0.f;
                v = wave_scan_incl(v);
                const float c = carry + v; carry = __int_as_float(__builtin_amdgcn_readlane(__float_as_int(c), 63));
                FB[(size_t)bh * LP + tp] = (tp >= PADF) ? -c * 11.313708498984761f : -__builtin_inff(); } } }
    }
    xcd_barrier(xbar);

    {
        PH_BEGIN
        bf16_t* GQN = WSP(bf16_t, O_GQN); bf16_t* GKN = WSP(bf16_t, O_GKN); bf16_t* GVN = WSP(bf16_t, O_GVN); bf16_t* WV = WSP(bf16_t, O_WV); bf16_t* WK = WSP(bf16_t, O_WK); bf16_t* KT = WSP(bf16_t, O_KT); bf16_t* QKB = WSP(bf16_t, O_QK);
        float* BETA = WSP(float, O_BETA); float* GG = WSP(float, O_GG); float* GC = WSP(float, O_GC);
        typedef float f32x2 __attribute__((ext_vector_type(2)));
        constexpr int UB = 53248;
        constexpr int NPAIR = NB * NH * NCH / 2;
        bf16_t* WUP = WSP(bf16_t, O_WUP); bf16_t* WDN = WSP(bf16_t, O_WDN); bf16_t* WOG = WSP(bf16_t, O_WOG); bf16_t* WOF = WSP(bf16_t, O_WOF); bf16_t* WOUT = WSP(bf16_t, O_WOUT);
        constexpr int I_UP = 32 * (DFF / 32), I_DN = 128 * (DM / 32), I_SQ = 32 * (DM / 32), NDEF = I_UP + I_DN + 3 * I_SQ;
        const int nslots = (NDEF + G - 1) / G; int dslot = wave - 4;
        LAS float* dscr = (LAS float*)(ldsl + 2 * UB + (wave & 3) * 8448);
#define DEFER_ITEMS(maxn_) do { for (int k_ = 0; k_ < (maxn_) && dslot < nslots; ++k_, dslot += 4) { const int id_ = dslot * G + bx; if (id_ < NDEF) {                       \
                if (id_ < I_UP) p0_transpose_item(ap->w_up, DM, DFF, 0, WUP, 0, dscr, id_ / (DFF / 32), id_ % (DFF / 32), lane);                                                  \
                else if (id_ < I_UP + I_DN) { const int r_ = id_ - I_UP; p0_transpose_item(ap->w_down, DFF, DM, 0, WDN, 0, dscr, r_ / (DM / 32), r_ % (DM / 32), lane); }                 \
                else { const int r_ = id_ - I_UP - I_DN, w_ = r_ / I_SQ, q_ = r_ % I_SQ;                                                                                              \
                    p0_transpose_item(w_ == 0 ? ap->w_o_gdn : (w_ == 1 ? ap->w_o_fox : ap->w_out), DM, DM, 0, w_ == 0 ? WOG : (w_ == 1 ? WOF : WOUT), 0, dscr, q_ / (DM / 32), q_ % (DM / 32), lane); } } } } while (0)
        for (int p = bx; p < NPAIR; p += G) {
            { const int half = tid >> 8, t = tid & 255, w4 = wave & 3;
              unsigned char* hb = lds + half * UB; float* Asm = (float*)hb; bf16_t* Ks = (bf16_t*)(hb + 16384); bf16_t* Vs = (bf16_t*)(hb + 32768); float* gcs = (float*)(hb + 49152); float* betas = gcs + 64; float* egs = gcs + 128;
              const int unit = 2 * p + half; const int bh = unit / NCH, n = unit % NCH, b = bh >> 4, h = bh & 15; const size_t R0 = (size_t)b * LP + 64 * n;
              if (w4 == 0) { float gv = GG[(size_t)bh * LP + 64 * n + lane]; const float be = BETA[(size_t)bh * LP + 64 * n + lane];
                  gv = wave_scan_incl(gv);
                  gcs[lane] = gv; betas[lane] = be; egs[lane] = __expf(gv); GC[(size_t)unit * 64 + lane] = gv; }
#pragma unroll
              for (int i = 0; i < 4; ++i) { const int ch = t + 256 * i, r = ch >> 4, c8 = (ch & 15) * 8;
                  *(u32x4*)(Ks + r * 128 + c8) = *(const u32x4*)(GKN + (R0 + r) * DM + h * 128 + c8);
                  *(u32x4*)(Vs + r * 128 + c8) = *(const u32x4*)(GVN + (R0 + r) * DM + h * 128 + c8); }
              const int qi = w4 >> 1, qj = w4 & 1, c = lane & 31, hi = lane >> 5;
              f32x16 mm = {}, qq = {};
              if (!(qi == 0 && qj == 1)) {
                  const bf16_t* ki = GKN + (R0 + 32 * qi + c) * DM + h * 128 + 8 * hi; const bf16_t* qi_ = GQN + (R0 + 32 * qi + c) * DM + h * 128 + 8 * hi;
                  const bf16_t* kj = GKN + (R0 + 32 * qj + c) * DM + h * 128 + 8 * hi;
#pragma unroll
                  for (int s = 0; s < 8; ++s) { const bf16x8 ak = *(const bf16x8*)(ki + 16 * s), aq = *(const bf16x8*)(qi_ + 16 * s), bk = *(const bf16x8*)(kj + 16 * s);
                      mm = MFMA32(ak, bk, mm); qq = MFMA32(aq, bk, qq); } }
              __syncthreads();
              bf16_t* qko = QKB + (size_t)unit * 4096; const int j = 32 * qj + c; const float gj = gcs[j];
#pragma unroll
              for (int r = 0; r < 16; ++r) { const int i = 32 * qi + fox::crow(r, hi); const float dec = __expf(gcs[i] - gj);
                  const float av = (i > j) ? betas[i] * mm[r] * dec : 0.f; const float qv = (i >= j) ? qq[r] * dec : 0.f;
                  Asm[i * 64 + j] = av; qko[i * 64 + j] = f2bf(qv); }
              __syncthreads(); }
            if (wave < 4) {
              const int u2 = wave >> 1, t = tid & 127;
              const unsigned char* hb = lds + u2 * UB; const float* Asm = (const float*)hb; const bf16_t* Ks = (const bf16_t*)(hb + 16384) + t; const bf16_t* Vs = (const bf16_t*)(hb + 32768) + t;
              const float* betas = (const float*)(hb + 49152) + 64; const float* egs = betas + 64;
              const int unit = 2 * p + u2;
              bf16_t* dv = WV + (size_t)unit * 8192 + t; bf16_t* dk = WK + (size_t)unit * 8192 + t;
              f32x2 w[64]; unsigned kpk[4]; bf16_t* kto = KT + (size_t)unit * 8192 + t * 64;
#pragma clang loop unroll(full)
              for (int i = 0; i < 64; ++i) {
                  const bf16_t kraw = Ks[i * 128]; const float be = betas[i];
                  f32x2 acc; acc.x = bf2f(Vs[i * 128]) * be; acc.y = bf2f(kraw) * be * egs[i];
                  if (i & 1) kpk[(i >> 1) & 3] |= (unsigned)kraw << 16; else kpk[(i >> 1) & 3] = kraw;
                  if ((i & 7) == 7) { u32x4 o; o.x = kpk[0]; o.y = kpk[1]; o.z = kpk[2]; o.w = kpk[3]; *(u32x4*)(kto + (i & ~7)) = o; }
                  const int arow = __float_as_int(Asm[i * 64 + lane]);
#pragma clang loop unroll(full)
                  for (int j0 = 0; j0 < 64; j0 += 8) {
                      if (j0 < i) {
                      float sc[8];
#pragma clang loop unroll(full)
                      for (int jj = 0; jj < 8; ++jj) sc[jj] = (j0 + jj < i) ? -__int_as_float(__builtin_amdgcn_readlane(arow, j0 + jj)) : 0.f;
#pragma clang loop unroll(full)
                      for (int jj = 0; jj < 8; ++jj) if (j0 + jj < i) { f32x2 s2; s2.x = sc[jj]; s2.y = sc[jj]; acc = __builtin_elementwise_fma(s2, w[j0 + jj], acc); }
                      }
                  }
                  w[i] = acc;
                  dv[i * 128] = f2bf(acc.x); dk[i * 128] = f2bf(acc.y); }
            } else { DEFER_ITEMS(7); }
            __syncthreads();
        }
        if (wave >= 4) { DEFER_ITEMS(1 << 30); }
#undef DEFER_ITEMS
    }
    xcd_barrier(xbar);

    {
        PH_BEGIN
        unsigned* ctl = WSP(unsigned, O_CTL);
        bf16_t* GQN = WSP(bf16_t, O_GQN); bf16_t* WV = WSP(bf16_t, O_WV); bf16_t* WK = WSP(bf16_t, O_WK); bf16_t* KT = WSP(bf16_t, O_KT); bf16_t* QKB = WSP(bf16_t, O_QK); float* GC = WSP(float, O_GC);
        bf16_t* Z = WSP(bf16_t, O_Z); bf16_t* YA = WSP(bf16_t, O_YA); bf16_t* YB = WSP(bf16_t, O_YB); bf16_t* FQN = WSP(bf16_t, O_FQN); bf16_t* FKN = WSP(bf16_t, O_FKN); bf16_t* FVN = WSP(bf16_t, O_FVN); float* FB = WSP(float, O_FB);
        if (bx < 2 * NB * NH) {
            const int bh = bx >> 1, half = bx & 1, b = bh >> 4, h = bh & 15, m16 = lane & 15, g4 = lane >> 4;
            constexpr int GBUF = 65792, G_WK = 0, G_Q = 16384, G_QK = 32768, G_KT = 40960, G_WV = 57344, G_GC = 65536;
            const unsigned lds0 = (unsigned)(uintptr_t)ldsl;
#define CROW(t_, i_) (32 * ((t_) >> 1) + 8 * ((i_) >> 2) + 4 * ((t_) & 1) + ((i_) & 3))
#define KEY256(row_) (((((row_) >> 3) & 3) << 2) | ((row_) & 3))
#define KEY128(row_) (((((row_) >> 3) & 3) << 1) | (((row_) >> 1) & 1))
            if (wave >= 4) {
                const int tl = tid - 256, lw = wave - 4;
                for (int n = 0; n < NCH; ++n) {
                    const int un_ = bh * NCH + n; const unsigned db_ = (unsigned)__builtin_amdgcn_readfirstlane((int)(lds0 + (n & 1) * GBUF + lw * 1024));
#pragma unroll
                    for (int r_ = 0; r_ < 4; ++r_) { const int P_ = r_ * 256 + tl;
                        { const int row_ = P_ >> 4, ch_ = (P_ & 15) ^ KEY256(row_);
                          glds16(WK + (size_t)un_ * 8192 + row_ * 128 + ch_ * 8, db_ + G_WK + r_ * 4096);
                          glds16(GQN + ((size_t)b * LP + 64 * n + row_) * DM + h * 128 + ch_ * 8, db_ + G_Q + r_ * 4096); }
                        { const int row_ = P_ >> 3, ch_ = (P_ & 7) ^ KEY128(row_);
                          glds16(KT + (size_t)un_ * 8192 + row_ * 64 + ch_ * 8, db_ + G_KT + r_ * 4096); } }
#pragma unroll
                    for (int r_ = 0; r_ < 2; ++r_) { const int P_ = r_ * 256 + tl, row_ = P_ >> 3, cs_ = P_ & 7;
                        glds16(QKB + (size_t)un_ * 4096 + row_ * 64 + (cs_ ^ KEY128(row_)) * 8, db_ + G_QK + r_ * 4096);
                        glds16(WV + (size_t)un_ * 8192 + row_ * 128 + half * 64 + cs_ * 8, db_ + G_WV + r_ * 4096); }
                    if (tl < 16) glds16(GC + (size_t)un_ * 64 + tl * 4, db_ + G_GC);
                    asm volatile("s_waitcnt vmcnt(0)" ::: "memory"); __builtin_amdgcn_s_barrier();
                }
                __builtin_amdgcn_s_barrier();
            } else {
                const int vl = 16 * wave;
#define FR256(tile_, ct_, ks_) (*(const LAS bf16x8*)((tile_) + CROW(ct_, m16) * 256 + (((4 * (ks_) + g4) ^ m16) << 4)))
#define FR128(tile_, t_, s2_) (*(const LAS bf16x8*)((tile_) + CROW(t_, m16) * 128 + (((4 * (s2_) + g4) ^ (((m16 >> 2) << 1) | ((m16 >> 1) & 1))) << 4)))
                f32x4 Sacc[8];
#pragma unroll
                for (int i = 0; i < 8; ++i) Sacc[i] = (f32x4){0.f, 0.f, 0.f, 0.f};
                constexpr float L2E = 1.4426950408889634f;
                __builtin_amdgcn_s_barrier();
                for (int n = 0; n < NCH; ++n) {
                    const LAS unsigned char* tb = ldsl + (n & 1) * GBUF;
                    const LAS float* gcl = (const LAS float*)(tb + G_GC); const LAS bf16_t* wvl = (const LAS bf16_t*)(tb + G_WV) + vl + m16;
                    bf16x8 Sb[4];
#pragma unroll
                    for (int ks = 0; ks < 4; ++ks) Sb[ks] = packacc(Sacc[2 * ks], Sacc[2 * ks + 1]);
                    f32x4 Uu[4], O1[4], gcv[4];
#pragma unroll
                    for (int ct = 0; ct < 4; ++ct) { Uu[ct] = (f32x4){0.f, 0.f, 0.f, 0.f}; O1[ct] = Uu[ct]; gcv[ct] = *(const LAS f32x4*)(gcl + CROW(ct, 4 * g4)) * L2E; }
                    const float gl = gcl[63] * L2E;
#pragma unroll
                    for (int ct = 0; ct < 4; ++ct) {
#pragma unroll
                        for (int ks = 0; ks < 4; ++ks) { Uu[ct] = MFMA16(FR256(tb + G_WK, ct, ks), Sb[ks], Uu[ct]); O1[ct] = MFMA16(FR256(tb + G_Q, ct, ks), Sb[ks], O1[ct]); }
                        __builtin_amdgcn_sched_barrier(0); }
                    f32x4 vn[4], vs[4];
#pragma unroll
                    for (int ct = 0; ct < 4; ++ct)
#pragma unroll
                        for (int r = 0; r < 4; ++r) { vn[ct][r] = bf2f(wvl[CROW(ct, 4 * g4 + r) * 64]) - Uu[ct][r];
                            O1[ct][r] *= __builtin_amdgcn_exp2f(gcv[ct][r]); vs[ct][r] = vn[ct][r] * __builtin_amdgcn_exp2f(gl - gcv[ct][r]); }
                    bf16x8 vnb[2], vsb[2];
#pragma unroll
                    for (int s2 = 0; s2 < 2; ++s2) { vnb[s2] = packacc(vn[2 * s2], vn[2 * s2 + 1]); vsb[s2] = packacc(vs[2 * s2], vs[2 * s2 + 1]); }
#pragma unroll
                    for (int ct = 0; ct < 4; ++ct) {
#pragma unroll
                        for (int s2 = 0; s2 < 2; ++s2) O1[ct] = MFMA16(FR128(tb + G_QK, ct, s2), vnb[s2], O1[ct]);
                        if (ct & 1) __builtin_amdgcn_sched_barrier(0); }
                    const float glast = __builtin_amdgcn_exp2f(gl);
#pragma unroll
                    for (int mt = 0; mt < 8; ++mt) { Sacc[mt] *= glast;
#pragma unroll
                        for (int s2 = 0; s2 < 2; ++s2) Sacc[mt] = MFMA16(FR128(tb + G_KT, mt, s2), vsb[s2], Sacc[mt]);
                        if ((mt & 3) == 3) __builtin_amdgcn_sched_barrier(0); }
                    if (n >= 1) {
                        bf16_t* op = YA + ((size_t)b * SEQ + 64 * (n - 1)) * DM + h * 128 + 64 * half + vl + m16;
#pragma unroll
                        for (int ct = 0; ct < 4; ++ct)
#pragma unroll
                            for (int r = 0; r < 4; ++r) op[(unsigned)(CROW(ct, 4 * g4 + r) * DM)] = f2bf(O1[ct][r]);
                    }
                    __builtin_amdgcn_s_barrier();
                }
#undef FR256
#undef FR128
            }
#undef CROW
#undef KEY256
#undef KEY128
            asm volatile("s_waitcnt vmcnt(0) lgkmcnt(0)" ::: "memory");
            __syncthreads();
            if (tid == 0) { __builtin_amdgcn_fence(__ATOMIC_RELEASE, "agent"); asm volatile("s_waitcnt vmcnt(0)" ::: "memory"); (void)xb_add(ctl + CW_SCAN, 1u); }
        }
        {
            volatile int* misc = (volatile int*)(lds + MISC_OFF);
            auto mkref = [&](int L) { const int v_ = L & 63, qb = 15 - (v_ >> 2), bh = (L >> 6) + 8 * (v_ & 3), b = bh >> 4, h = bh & 15; fox::BlockRef r;
                r.Q = FQN + ((size_t)b * LP + XOFF + qb * 256) * DM + h * 128; r.K = FKN + (size_t)b * LP * DM + h * 128; r.V = FVN + (size_t)b * LP * DM + h * 128;
                r.O = YB + ((size_t)b * SEQ + qb * 256) * DM + h * 128; r.bias = FB + (size_t)bh * LP; r.P0 = XOFF + qb * 256; return r; };
            const int xcd = (int)(__builtin_amdgcn_s_getreg((3 << 11) | 20) & 7u);
#define FOX_TAKE(slot_) do { if (tid == 0) { int code_ = -1; for (int q_ = 0; q_ < 8; ++q_) { const int x_ = (xcd + q_) & 7; const int v_ = (int)atomicAdd(ctl + CW_QUEUE + 64 * x_, 1u); if (v_ < 64) { code_ = x_ * 64 + v_; break; } } misc[slot_] = code_; } } while (0)
            FOX_TAKE(0);
            __syncthreads();
            int L = __builtin_amdgcn_readfirstlane(misc[0]);
            if (L >= 0) {
                fox::BlockRef cur = mkref(L); fox::Seam S; int par = 0;
                fox::causal_prime(cur, (char*)lds, S, par);
                for (;;) {
                    FOX_TAKE(1);
                    __syncthreads();
                    const int Ln = __builtin_amdgcn_readfirstlane(misc[1]); const bool last = Ln < 0;
                    const fox::BlockRef nxt = last ? cur : mkref(Ln);
                    fox::causal_block(cur, nxt, (char*)lds, S, par);
                    if (last) break;
                    cur = nxt; par ^= 1;
                }
            }
#undef FOX_TAKE
        }
        {
            { unsigned sp_ = 0; while ((unsigned)__builtin_amdgcn_readfirstlane((int)xb_ld(ctl + CW_SCAN)) < 64u) { __builtin_amdgcn_s_sleep(4); if (++sp_ > (1u << 22)) break; } }
            __builtin_amdgcn_fence(__ATOMIC_ACQUIRE, "agent");
        const int sub = lane >> 4, l16 = lane & 15;
        const f32x4 g0 = *(const f32x4*)(ap->gdn_g + l16 * 8), g1 = *(const f32x4*)(ap->gdn_g + l16 * 8 + 4);
        for (int it0 = gw; it0 < MX * NH / 4; it0 += 4 * NGW) {
            u32x4 ou[4], zu[4];
#pragma unroll
            for (int k = 0; k < 4; ++k) { const int it = it0 + k * NGW; const size_t off = (size_t)(it * 4 + sub) * 128 + l16 * 8;
                if (it < MX * NH / 4) { ou[k] = *(const u32x4*)(YA + off); zu[k] = *(const u32x4*)(Z + off); } else { ou[k] = (u32x4){0u, 0u, 0u, 0u}; zu[k] = ou[k]; } }
#pragma unroll
            for (int k = 0; k < 4; ++k) { const int it = it0 + k * NGW; const size_t off = (size_t)(it * 4 + sub) * 128 + l16 * 8;
                float o[8], z[8];
                o[0] = __uint_as_float(ou[k].x << 16); o[1] = __uint_as_float(ou[k].x & 0xffff0000u); o[2] = __uint_as_float(ou[k].y << 16); o[3] = __uint_as_float(ou[k].y & 0xffff0000u);
                o[4] = __uint_as_float(ou[k].z << 16); o[5] = __uint_as_float(ou[k].z & 0xffff0000u); o[6] = __uint_as_float(ou[k].w << 16); o[7] = __uint_as_float(ou[k].w & 0xffff0000u);
                z[0] = __uint_as_float(zu[k].x << 16); z[1] = __uint_as_float(zu[k].x & 0xffff0000u); z[2] = __uint_as_float(zu[k].y << 16); z[3] = __uint_as_float(zu[k].y & 0xffff0000u);
                z[4] = __uint_as_float(zu[k].z << 16); z[5] = __uint_as_float(zu[k].z & 0xffff0000u); z[6] = __uint_as_float(zu[k].w << 16); z[7] = __uint_as_float(zu[k].w & 0xffff0000u);
                float ss = 0.f;
#pragma unroll
                for (int e = 0; e < 8; ++e) ss += o[e] * o[e];
                ss = sum16(ss);
                const float rstd = rsqrtf(ss * (1.f / DH) + EPS);
                float y[8];
#pragma unroll
                for (int e = 0; e < 8; ++e) y[e] = o[e] * rstd * (e < 4 ? g0[e] : g1[e - 4]) * (z[e] * __builtin_amdgcn_rcpf(1.f + __expf(-z[e])));
                u32x4 w; w.x = cvt_pk_bf16(y[0], y[1]); w.y = cvt_pk_bf16(y[2], y[3]); w.z = cvt_pk_bf16(y[4], y[5]); w.w = cvt_pk_bf16(y[6], y[7]);
                if (it < MX * NH / 4) *(u32x4*)(YA + off) = w; }
        }
        }
    }
    xcd_barrier(xbar);

    {
        PH_BEGIN
        bf16_t* YA = WSP(bf16_t, O_YA); bf16_t* WOG = WSP(bf16_t, O_WOG); bf16_t* GA = WSP(bf16_t, O_GA); bf16_t* GB = WSP(bf16_t, O_GB); bf16_t* MIX = WSP(bf16_t, O_MIX);
        pg8::Gemm g{YA, WOG, MX, 2 * DM, DM, 8, (size_t)(O_YB - O_YA)}; pg8::PairOrder S{MX / 256, DM / 256, G, bx};
        pg8::EpiMix E{GA, GB, MIX};
        pg8::gemm_phase<pg8::EpiMix, pg8::PairOrder>(ldsl, g, S, E);
    }
    xcd_barrier(xbar);
    {
        PH_BEGIN
        bf16_t* MIX = WSP(bf16_t, O_MIX); bf16_t* WOUT = WSP(bf16_t, O_WOUT); bf16_t* A2 = WSP(bf16_t, O_A2); float* SS1 = (float*)(WSP(unsigned, O_CTL) + CW_SS1);
        pg8::Gemm g{MIX, WOUT, MX, DM, DM, 1 << 30, 0}; pg8::StaticOrder S; S.init(MX, DM, G, bx);
        pg8::EpiRes E{ap->x, ap->out, A2, ap->mlp_g, SS1};
        pg8::gemm_phase<pg8::EpiRes, pg8::StaticOrder>(ldsl, g, S, E);
    }
    xcd_barrier(xbar);
    {
        PH_BEGIN
        bf16_t* A2 = WSP(bf16_t, O_A2); bf16_t* WUP = WSP(bf16_t, O_WUP); bf16_t* HID = WSP(bf16_t, O_HID); float* SS1 = (float*)(WSP(unsigned, O_CTL) + CW_SS1);
        pg8::Gemm g{A2, WUP, MX, DFF, DM, 1 << 30, 0}; pg8::StaticOrder S; S.init(MX, DFF, G, bx);
        pg8::EpiUp E{SS1, HID};
        pg8::gemm_phase<pg8::EpiUp, pg8::StaticOrder>(ldsl, g, S, E);
    }
    xcd_barrier(xbar);
    {
        PH_BEGIN
        bf16_t* HID = WSP(bf16_t, O_HID); bf16_t* WDN = WSP(bf16_t, O_WDN); float* SS2 = (float*)(WSP(unsigned, O_CTL) + CW_SS2);
        pg8::Gemm g{HID, WDN, MX, DM, DFF, 1 << 30, 0}; pg8::StaticOrder S; S.init(MX, DM, G, bx);
        if (G == 256) { pg8::EpiFinal E{ap->out, ap->out, ap->final_g, SS2, WSP(unsigned, O_CTL) + CW_PANEL};
            pg8::gemm_phase<pg8::EpiFinal, pg8::StaticOrder>(ldsl, g, S, E); }
        else { pg8::EpiRes E{ap->out, ap->out, nullptr, nullptr, SS2};
            pg8::gemm_phase<pg8::EpiRes, pg8::StaticOrder>(ldsl, g, S, E); }
    }
    if (gridDim.x != 256) {
    xcd_barrier(xbar);
    {
        PH_BEGIN
        float* SS2 = (float*)(WSP(unsigned, O_CTL) + CW_SS2);
        for (int m = gw; m < MX; m += NGW) {
            const float rstd = rsqrtf(SS2[m] * (1.f / DM) + EPS);
            f32x4* o = (f32x4*)(ap->out + (size_t)m * DM) + lane; const f32x4* gr = (const f32x4*)ap->final_g + lane;
#pragma unroll
            for (int j = 0; j < 8; ++j) { f32x4 v = o[64 * j]; const f32x4 gg = gr[64 * j]; v = v * rstd; v[0] *= gg[0]; v[1] *= gg[1]; v[2] *= gg[2]; v[3] *= gg[3]; o[64 * j] = v; }
        }
    }
    }
}

extern "C" void kernel_launch(void* const* d_in, const int* in_sizes, int n_in, void* d_out, int out_size, void* d_ws, size_t ws_size, hipStream_t stream) {
    static int grid = 0;
    if (grid == 0) {
        if (n_in != 18 || in_sizes[0] != MX * DM || out_size != MX * DM || ws_size < WS_END) { fprintf(stderr, "kernel_launch: unexpected shapes (n_in %d, in0 %d, out %d, ws %zu < %zu)\n", n_in, n_in > 0 ? in_sizes[0] : -1, out_size, ws_size, (size_t)WS_END); grid = -1; return; }
        int dev = 0, cus = 0, per_cu = 0;
        (void)hipGetDevice(&dev); (void)hipDeviceGetAttribute(&cus, hipDeviceAttributeMultiprocessorCount, dev);
        if (hipFuncSetAttribute((const void*)mk_fwd, hipFuncAttributeMaxDynamicSharedMemorySize, LDS_BYTES) != hipSuccess) { fprintf(stderr, "kernel_launch: hipFuncSetAttribute failed\n"); grid = -1; return; }
        if (hipOccupancyMaxActiveBlocksPerMultiprocessor(&per_cu, (const void*)mk_fwd, 512, LDS_BYTES) != hipSuccess || per_cu < 1) { fprintf(stderr, "kernel_launch: occupancy query says %d\n", per_cu); per_cu = 1; }
        (void)hipGetLastError();
        grid = cus > 0 ? cus : 256;
    }
    if (grid < 0) return;
    (void)hipMemsetAsync((char*)d_ws + O_CTL, 0, CTL_BYTES, stream);
    Args a{};
    const float** p = (const float**)&a;
    for (int i = 0; i < 18; ++i) p[i] = (const float*)d_in[i];
    a.out = (float*)d_out; a.ws = (unsigned char*)d_ws;
    void* kargs[] = {&a};
    hipError_t e = hipLaunchCooperativeKernel((const void*)mk_fwd, dim3(grid), dim3(512), kargs, LDS_BYTES, stream);
    if (e != hipSuccess) fprintf(stderr, "kernel_launch: cooperative launch failed: %s (grid %d)\n", hipGetErrorString(e), grid);
}
```

```cpp
#include <hip/hip_runtime.h>
#include <hip/hip_bf16.h>
#include <hip/hip_cooperative_groups.h>
#include <cstdio>
#include <cstdint>
namespace cg = cooperative_groups;

#define DI __device__ __forceinline__
#define LAS __attribute__((address_space(3)))
typedef unsigned short bf16_t;
typedef short bf16x8 __attribute__((ext_vector_type(8)));
typedef short s16x4 __attribute__((ext_vector_type(4)));
typedef float f32x4 __attribute__((ext_vector_type(4)));
typedef float f32x16 __attribute__((ext_vector_type(16)));
typedef unsigned u32x4 __attribute__((ext_vector_type(4)));
typedef unsigned u32x2 __attribute__((ext_vector_type(2)));

constexpr int DM = 2048, NH = 16, DH = 128, DFF = 8192, SEQ = 4096, NB = 2, NMETA = 16;
constexpr int LP = 4160;
constexpr int PADF = 48, XOFF = 64;
constexpr int RP = NB * LP;
constexpr int MX = NB * SEQ;
constexpr int NIN = 18480, NBIG = 18432, NSM = 48;
constexpr int NCH = 65;
constexpr float EPS = 1e-6f;

constexpr size_t SZ_ROWS_P = (size_t)RP * DM * 2;
constexpr size_t SZ_ROWS_X = (size_t)MX * DM * 2;
constexpr size_t O_CTL = 0, CTL_BYTES = 1u << 20;
constexpr size_t O_WTIN = CTL_BYTES;
constexpr size_t SZ_WTIN = (size_t)(NBIG + 64) * DM * 2;
constexpr size_t O_U = O_WTIN + SZ_WTIN;
constexpr size_t SZ_U = (size_t)(MX + NMETA) * DM * 2;
constexpr size_t O_GQN = O_WTIN, O_GKN = O_GQN + SZ_ROWS_P, O_GVN = O_GKN + SZ_ROWS_P;
static_assert(3 * SZ_ROWS_P <= SZ_WTIN + SZ_U, "alias");
constexpr size_t O_YA = O_GKN, O_YB = O_GVN;
constexpr size_t O_WOG = O_U + SZ_U;
constexpr size_t O_WOF = O_WOG + (size_t)DM * DM * 2;
constexpr size_t O_WOUT = O_WOF + (size_t)DM * DM * 2;
constexpr size_t O_WUP = O_WOUT + (size_t)DM * DM * 2;
constexpr size_t O_WDN = O_WUP + (size_t)DFF * DM * 2;
constexpr size_t O_GRAW = O_WDN + (size_t)DFF * DM * 2;
constexpr size_t SZ_RAW = (size_t)RP * 6144 * 2;
constexpr size_t O_WV = O_GRAW, O_WK = O_WV + SZ_ROWS_P, O_KT = O_WK + SZ_ROWS_P;
constexpr size_t O_A2 = O_GRAW;
constexpr size_t O_FRAW = O_GRAW + SZ_RAW;
constexpr size_t O_MIX = O_FRAW;
constexpr size_t O_HID = O_FRAW;
constexpr size_t O_FQN = O_FRAW, O_FKN = O_FRAW + SZ_ROWS_P, O_FVN = O_FRAW + 2 * SZ_ROWS_P;
constexpr size_t O_RSV = O_FRAW + SZ_RAW;
static_assert((size_t)MX * DFF * 2 <= SZ_RAW + 2 * SZ_ROWS_P, "alias hid");
constexpr size_t O_Z = O_RSV + 2 * SZ_ROWS_P;
constexpr size_t O_GA = O_Z + SZ_ROWS_X, O_GB = O_GA + SZ_ROWS_X;
constexpr size_t O_QK = O_GB + SZ_ROWS_X;
constexpr size_t O_SM = O_QK + (size_t)NB * NH * NCH * 64 * 64 * 2;
constexpr size_t O_BETA = O_SM + (size_t)RP * NSM * 4;
constexpr size_t SZ_SC = (size_t)NB * NH * LP * 4;
constexpr size_t O_GG = O_BETA + SZ_SC, O_FB = O_GG + SZ_SC, O_GC = O_FB + SZ_SC, WS_END = O_GC + SZ_SC;
constexpr int CW_QUEUE = 64;
constexpr int CW_SS1 = 1024;
constexpr int CW_SS2 = 1024 + 8192;
constexpr int CW_BAR = 32768;
constexpr int CW_SCAN = 45056;
constexpr int CW_PANEL = 40960;

constexpr int RING_BYTES = 131072;
constexpr int LDS_BYTES = 155648;
constexpr int MISC_OFF = LDS_BYTES - 256;

DI unsigned cvt_pk_bf16(float lo, float hi) { unsigned r; asm volatile("v_cvt_pk_bf16_f32 %0, %1, %2" : "=v"(r) : "v"(lo), "v"(hi)); return r; }
DI float bf2f(bf16_t v) { return __uint_as_float((unsigned)v << 16); }
DI bf16_t f2bf(float f) { return (bf16_t)(cvt_pk_bf16(f, 0.f) & 0xffffu); }
DI float wave_sum(float v) {
#pragma unroll
    for (int o = 1; o < 64; o <<= 1) v += __shfl_xor(v, o);
    return v;
}
#define DPP_ADD(v, ctrl) ((v) + __int_as_float(__builtin_amdgcn_update_dpp(0, __float_as_int(v), (ctrl), 0xf, 0xf, true)))
DI float sum16(float v) { v = DPP_ADD(v, 0xB1); v = DPP_ADD(v, 0x4E); v = DPP_ADD(v, 0x141); v = DPP_ADD(v, 0x140); return v; }
DI float sum4(float v) { v = DPP_ADD(v, 0xB1); v = DPP_ADD(v, 0x4E); return v; }
#define DPP_Z(v, ctrl, rmask) __int_as_float(__builtin_amdgcn_update_dpp(0, __float_as_int(v), (ctrl), (rmask), 0xf, true))
DI float wave_scan_incl(float v) {
    v += DPP_Z(v, 0x111, 0xf); v += DPP_Z(v, 0x112, 0xf); v += DPP_Z(v, 0x114, 0xf); v += DPP_Z(v, 0x118, 0xf);
    v += DPP_Z(v, 0x142, 0xa); v += DPP_Z(v, 0x143, 0xc);
    return v;
}
DI float sigmoidf_(float x) { return 1.f / (1.f + __expf(-x)); }

namespace pg8 {
constexpr int BM = 256, BK = 64, HALF = 128, HTB = HALF * BK * 2, STAGE_BYTES = 8 * HTB, NXCD = 8, WGM = 8;
__host__ __device__ __forceinline__ int lds_byte(int r, int c) { const int st = (r >> 4) * 2 + (c >> 5), rr = r & 15, cc = c & 31, ob = rr * 64 + cc * 2; return st * 1024 + (ob ^ (((ob >> 9) & 1) << 5)); }
__host__ __device__ __forceinline__ void stage_rc(int b, int& R, int& C) { const int st = b / 1024, sb = b % 1024, swz = sb ^ (((sb >> 9) & 1) << 5); R = (st >> 1) * 16 + swz / 64; C = (st & 1) * 32 + (swz % 64) / 2; }
__host__ __device__ __forceinline__ int perm32(int rho) { const int n = rho >> 4, i = rho & 15; return 8 * (i >> 2) + 4 * n + (i & 3); }
struct Unit { int pm, pn; };
struct Gemm { const bf16_t* A; const bf16_t* Bt; int M, N, K; int asplit; size_t aoff2; };
struct StaticOrder {
    int nM, nN, nwg, G, c;
    __device__ void init(int M, int N, int G_, int c_) { nM = M / BM; nN = N / BM; nwg = nM * nN; G = G_; c = c_; }
    __device__ bool next(int i, Unit& u) const {
        const long L = (long)i * G + c; if (L >= nwg) return false;
        int wgid = (int)L; { const int q = nwg / NXCD, r = nwg % NXCD, xcd = wgid % NXCD, off = wgid / NXCD; wgid = (xcd < r ? xcd * (q + 1) : r * (q + 1) + (xcd - r) * q) + off; }
        const int nig = WGM * nN, gid = wgid / nig, fm = gid * WGM, gsz = (nM - fm) < WGM ? (nM - fm) : WGM;
        u.pm = fm + ((wgid % nig) % gsz); u.pn = (wgid % nig) / gsz; return true;
    }
};
struct PairOrder {
    int nM, nNo, G, c;
    __device__ bool next(int i, Unit& u) const {
        const int T = c + (i >> 1) * G; if (T >= nM * nNo) return false;
        if (G == 256 && nM == 32 && nNo == 8) { const int x = c & 7, off = c >> 3;
            u.pm = 8 * (x >> 1) + (off & 7); u.pn = 4 * (x & 1) + (off >> 3) + (i & 1) * nNo; return true; }
        u.pm = T / nNo; u.pn = (T % nNo) + (i & 1) * nNo; return true;
    }
};
template <class Epi, class Sched>
__device__ __forceinline__ void gemm_phase(LAS unsigned char* lds, const Gemm g, const Sched& S, const Epi& E) {
    int tid = threadIdx.x; asm volatile("" : "+v"(tid));
    const int wid = __builtin_amdgcn_readfirstlane(tid >> 6), lane = tid & 63, wr = wid >> 2, wc = wid & 3, fr = lane & 15, fq = lane >> 4;
    const int K = g.K, nt = K / BK;
    unsigned voffA[2], voffB[2];
#pragma unroll
    for (int i = 0; i < 2; ++i) { int R, C; stage_rc(tid * 16 + i * 8192, R, C); const int Rb = Epi::PERM ? ((R & ~31) + perm32(R & 31)) : R;
        voffA[i] = (unsigned)(R * K + C) * 2u; voffB[i] = (unsigned)(Rb * K + C) * 2u; }
    const size_t kstep = (size_t)(BK * 2);
    const size_t hstep = (size_t)HALF * K * 2;
    const size_t tstep = 2 * hstep;
    const unsigned ldsw = (unsigned)wid * 1024u;
    const int aoff = lds_byte(wr * 64 + fr, fq * 8), boff = lds_byte(wc * 32 + fr, fq * 8);
#define PG8_SA(b, h) (((b) * 2 + (h)) * HTB)
#define PG8_SB(b, h) ((4 + (b) * 2 + (h)) * HTB)
#define PG8_STAGE(bufoff, gbase, voff) do { _Pragma("unroll") for (int _i = 0; _i < 2; ++_i) \
        __builtin_amdgcn_global_load_lds((const unsigned*)((const char*)(gbase) + (voff)[_i]), (LAS unsigned*)(lds + (bufoff) + ldsw + _i * 8192), 16, 0, 0); } while (0)
#define PG8_LDA(dst, b, h) do { _Pragma("unroll") for (int m = 0; m < 4; ++m) _Pragma("unroll") for (int k = 0; k < 2; ++k) dst[m][k] = *(const LAS bf16x8*)(lds + PG8_SA(b, h) + aoff + m * 2048 + k * 1024); } while (0)
#define PG8_LDB(dst, b, h) do { _Pragma("unroll") for (int n = 0; n < 2; ++n) _Pragma("unroll") for (int k = 0; k < 2; ++k) dst[n][k] = *(const LAS bf16x8*)(lds + PG8_SB(b, h) + boff + n * 2048 + k * 1024); } while (0)
#define PG8_MMA(ai, bj, At, Bt) do { __builtin_amdgcn_s_setprio(1); _Pragma("unroll") for (int m = 0; m < 4; ++m) _Pragma("unroll") for (int n = 0; n < 2; ++n) _Pragma("unroll") for (int k = 0; k < 2; ++k) \
        acc[ai][bj][m][n] = __builtin_amdgcn_mfma_f32_16x16x32_bf16(Bt[n][k], At[m][k], acc[ai][bj][m][n], 0, 0, 0); __builtin_amdgcn_s_setprio(0); } while (0)
#define PG8_WAIT_V(n) asm volatile("s_waitcnt vmcnt(" #n ")" ::: "memory")
#define PG8_WAIT_L(n) asm volatile("s_waitcnt lgkmcnt(" #n ")" ::: "memory")
#define PG8_BAR __builtin_amdgcn_s_barrier()
#define PG8_SCHED __builtin_amdgcn_sched_barrier(0)
#define PG8_APTR(u) ((const char*)g.A + (size_t)(u).pm * tstep + ((u).pn >= g.asplit ? g.aoff2 : (size_t)0))
    Unit cur, nxt; int ui = 0;
    if (!S.next(0, cur)) return;
    f32x4 acc[2][2][4][2];
#pragma unroll
    for (int a = 0; a < 2; ++a)
#pragma unroll
        for (int b = 0; b < 2; ++b)
#pragma unroll
            for (int m = 0; m < 4; ++m)
#pragma unroll
                for (int n = 0; n < 2; ++n) acc[a][b][m][n] = (f32x4){0.f, 0.f, 0.f, 0.f};
    bf16x8 At[4][2], B0[2][2], B1[2][2];
    const char* cA = PG8_APTR(cur); const char* cB = (const char*)g.Bt + (size_t)cur.pn * tstep;
    PG8_STAGE(PG8_SB(0, 0), cB, voffB); PG8_STAGE(PG8_SB(0, 1), cB + hstep, voffB); PG8_STAGE(PG8_SA(0, 0), cA, voffA); PG8_STAGE(PG8_SA(0, 1), cA + hstep, voffA);
    if (wr == 1) PG8_BAR;
    PG8_WAIT_V(2); PG8_BAR;
    PG8_STAGE(PG8_SB(1, 0), cB + kstep, voffB); PG8_STAGE(PG8_SA(1, 0), cA + kstep, voffA); PG8_STAGE(PG8_SB(1, 1), cB + hstep + kstep, voffB);
    PG8_WAIT_V(6); PG8_BAR;
    for (;;) {
        const bool has_next = S.next(ui + 1, nxt);
        const char* nA = has_next ? PG8_APTR(nxt) : cA; const char* nB = has_next ? (const char*)g.Bt + (size_t)nxt.pn * tstep : cB;
        for (int t = 0; t < nt; t += 2) {
            const bool last = (t == nt - 2);
            const char* a1 = cA + (size_t)(t + 1) * kstep;
            const char* a2 = last ? nA : cA + (size_t)(t + 2) * kstep; const char* b2 = last ? nB : cB + (size_t)(t + 2) * kstep;
            const char* a3 = a2 + kstep; const char* b3 = b2 + kstep;
            PG8_LDB(B0, 0, 0); PG8_LDB(B1, 0, 1); PG8_SCHED; PG8_LDA(At, 0, 0); PG8_STAGE(PG8_SA(1, 1), a1 + hstep, voffA);
            PG8_WAIT_V(8); PG8_WAIT_L(0); PG8_BAR; PG8_MMA(0, 0, At, B0); PG8_MMA(0, 1, At, B1); PG8_BAR; PG8_SCHED;
            PG8_LDA(At, 0, 1); PG8_STAGE(PG8_SB(0, 0), b2, voffB); PG8_STAGE(PG8_SB(0, 1), b2 + hstep, voffB); PG8_STAGE(PG8_SA(0, 0), a2, voffA);
            PG8_WAIT_V(8); PG8_WAIT_L(0); PG8_BAR; PG8_MMA(1, 0, At, B0); PG8_MMA(1, 1, At, B1); PG8_BAR; PG8_SCHED;
            PG8_LDB(B0, 1, 0); PG8_LDB(B1, 1, 1); PG8_SCHED; PG8_LDA(At, 1, 0); PG8_STAGE(PG8_SA(0, 1), a2 + hstep, voffA);
            PG8_WAIT_V(8); PG8_WAIT_L(0); PG8_BAR; PG8_MMA(0, 0, At, B0); PG8_MMA(0, 1, At, B1); PG8_BAR; PG8_SCHED;
            PG8_LDA(At, 1, 1); PG8_STAGE(PG8_SB(1, 0), b3, voffB); PG8_STAGE(PG8_SB(1, 1), b3 + hstep, voffB); PG8_STAGE(PG8_SA(1, 0), a3, voffA);
            PG8_WAIT_V(8); PG8_WAIT_L(0); PG8_BAR; PG8_MMA(1, 0, At, B0); PG8_MMA(1, 1, At, B1); PG8_BAR; PG8_SCHED;
        }
        if (wr == 0) PG8_BAR;
        const bool keep = E(acc, cur, wr, wc, fr, fq);
        if (!has_next) break;
        if (!keep) {
#pragma unroll
        for (int a = 0; a < 2; ++a)
#pragma unroll
            for (int b = 0; b < 2; ++b)
#pragma unroll
                for (int m = 0; m < 4; ++m)
#pragma unroll
                    for (int n = 0; n < 2; ++n) acc[a][b][m][n] = (f32x4){0.f, 0.f, 0.f, 0.f};
        }
        cur = nxt; cA = nA; cB = nB; ++ui;
        if (wr == 1) PG8_BAR;
    }
    PG8_WAIT_V(0);
    PG8_BAR;
#undef PG8_SA
#undef PG8_SB
#undef PG8_STAGE
#undef PG8_LDA
#undef PG8_LDB
#undef PG8_MMA
#undef PG8_WAIT_V
#undef PG8_WAIT_L
#undef PG8_BAR
#undef PG8_SCHED
#undef PG8_APTR
}

struct EpiIn {
    static constexpr bool PERM = true;
    bf16_t *graw, *z, *fqn, *fkn, *fvn, *ga, *gb; const float *qg, *kg; LAS float* xch;
    __device__ __forceinline__ bool operator()(f32x4 (&acc)[2][2][4][2], const Unit& u, int wr, int wc, int fr, int fq) const {
        const int colt = u.pn * BM; const int bb = u.pm >> 4;
        bf16_t* base; int ldc, c0, roff = 0; bool sg = false; const float* ng = nullptr;
        if (colt < 6144) { base = graw; ldc = 6144; c0 = colt; roff = XOFF + 64 * bb; }
        else if (colt < 8192) { base = z; ldc = DM; c0 = colt - 6144; }
        else if (colt < 10240) { base = fqn; ldc = DM; c0 = colt - 8192; roff = XOFF + 64 * bb; ng = qg; }
        else if (colt < 12288) { base = fkn; ldc = DM; c0 = colt - 10240; roff = XOFF + 64 * bb; ng = kg; }
        else if (colt < 14336) { base = fvn; ldc = DM; c0 = colt - 12288; roff = XOFF + 64 * bb; }
        else if (colt < 16384) { base = ga; ldc = DM; c0 = colt - 14336; sg = true; }
        else { base = gb; ldc = DM; c0 = colt - 16384; sg = true; }
        const int row0 = u.pm * BM + wr * 64 + fr + roff, col0 = c0 + wc * 32 + 8 * fq;
        if (ng) {
#pragma unroll
            for (int ai = 0; ai < 2; ++ai)
#pragma unroll
                for (int m = 0; m < 4; ++m)
#pragma unroll
                    for (int bj = 0; bj < 2; ++bj) { const f32x4 v0 = acc[ai][bj][m][0], v1 = acc[ai][bj][m][1];
                        float s = ((v0[0] * v0[0] + v0[1] * v0[1]) + (v0[2] * v0[2] + v0[3] * v0[3])) + ((v1[0] * v1[0] + v1[1] * v1[1]) + (v1[2] * v1[2] + v1[3] * v1[3]));
                        s += __shfl_xor(s, 16); s += __shfl_xor(s, 32);
                        if (fq == 0) xch[(ai * HALF + wr * 64 + m * 16 + fr) * 8 + bj * 4 + wc] = s; }
            asm volatile("s_waitcnt lgkmcnt(0)" ::: "memory"); __builtin_amdgcn_s_barrier(); asm volatile("" ::: "memory");
            f32x4 g0 = *(const f32x4*)(ng + wc * 32 + 8 * fq), g1 = *(const f32x4*)(ng + wc * 32 + 8 * fq + 4);
#pragma unroll
            for (int ai = 0; ai < 2; ++ai)
#pragma unroll
                for (int m = 0; m < 4; ++m)
#pragma unroll
                    for (int bj = 0; bj < 2; ++bj) { const f32x4 p = *(const LAS f32x4*)(xch + (ai * HALF + wr * 64 + m * 16 + fr) * 8 + bj * 4);
                        const float rstd = rsqrtf(((p[0] + p[1]) + (p[2] + p[3])) * (1.f / DH) + EPS);
#pragma unroll
                        for (int e = 0; e < 4; ++e) { acc[ai][bj][m][0][e] *= rstd * g0[e]; acc[ai][bj][m][1][e] *= rstd * g1[e]; } }
        }
#pragma unroll
        for (int ai = 0; ai < 2; ++ai)
#pragma unroll
            for (int m = 0; m < 4; ++m) { bf16_t* rowp = base + (size_t)(row0 + ai * HALF + m * 16) * ldc + col0;
#pragma unroll
                for (int bj = 0; bj < 2; ++bj) { f32x4 v0 = acc[ai][bj][m][0], v1 = acc[ai][bj][m][1];
                    if (sg) {
#pragma unroll
                        for (int e = 0; e < 4; ++e) { v0[e] = __builtin_amdgcn_rcpf(1.f + __expf(-v0[e])); v1[e] = __builtin_amdgcn_rcpf(1.f + __expf(-v1[e])); } }
                    u32x4 w; w.x = cvt_pk_bf16(v0[0], v0[1]); w.y = cvt_pk_bf16(v0[2], v0[3]); w.z = cvt_pk_bf16(v1[0], v1[1]); w.w = cvt_pk_bf16(v1[2], v1[3]);
                    *(u32x4*)(rowp + bj * HALF) = w; } }
        return false;
    }
};
struct EpiMix {
    static constexpr bool PERM = true;
    const bf16_t *ga, *gb; bf16_t* mix;
    __device__ __forceinline__ bool operator()(f32x4 (&acc)[2][2][4][2], const Unit& u, int wr, int wc, int fr, int fq) const {
        const bool part1 = u.pn >= 8; const int colt = (part1 ? u.pn - 8 : u.pn) * BM;
        const int row0 = u.pm * BM + wr * 64 + fr, col0 = colt + wc * 32 + 8 * fq;
#pragma unroll
        for (int ai = 0; ai < 2; ++ai)
#pragma unroll
            for (int m = 0; m < 4; ++m) { const size_t off = (size_t)(row0 + ai * HALF + m * 16) * DM + col0;
#pragma unroll
                for (int bj = 0; bj < 2; ++bj) {
                    const bf16x8 gbv = *(const bf16x8*)(gb + off + bj * HALF);
                    if (!part1) { const bf16x8 gav = *(const bf16x8*)(ga + off + bj * HALF);
#pragma unroll
                        for (int e = 0; e < 8; ++e) { const float r = bf2f((bf16_t)gav[e]) / fmaxf(bf2f((bf16_t)gbv[e]), 1e-30f); acc[ai][bj][m][e >> 2][e & 3] *= r; } }
                    else { f32x4 v0 = acc[ai][bj][m][0], v1 = acc[ai][bj][m][1];
#pragma unroll
                        for (int e = 0; e < 4; ++e) { v0[e] *= bf2f((bf16_t)gbv[e]); v1[e] *= bf2f((bf16_t)gbv[4 + e]); }
                        u32x4 w; w.x = cvt_pk_bf16(v0[0], v0[1]); w.y = cvt_pk_bf16(v0[2], v0[3]); w.z = cvt_pk_bf16(v1[0], v1[1]); w.w = cvt_pk_bf16(v1[2], v1[3]);
                        *(u32x4*)(mix + off + bj * HALF) = w; } } }
        return !part1;
    }
};
struct EpiRes {
    static constexpr bool PERM = false;
    const float* base; float* out; bf16_t* a2; const float* gvec; float* ss;
    __device__ __forceinline__ bool operator()(f32x4 (&acc)[2][2][4][2], const Unit& u, int wr, int wc, int fr, int fq) const {
        const int row0 = u.pm * BM + wr * 64 + fr, col0 = u.pn * BM + wc * 32 + 4 * fq;
#pragma unroll
        for (int ai = 0; ai < 2; ++ai)
#pragma unroll
            for (int m = 0; m < 4; ++m) { const int row = row0 + ai * HALF + m * 16; const size_t off = (size_t)row * DM + col0; float s = 0.f;
#pragma unroll
                for (int bj = 0; bj < 2; ++bj)
#pragma unroll
                    for (int n = 0; n < 2; ++n) { const int co = bj * HALF + n * 16;
                        const f32x4 bs = *(const f32x4*)(base + off + co); const f32x4 o = bs + acc[ai][bj][m][n];
                        *(f32x4*)(out + off + co) = o; s += (o[0] * o[0] + o[1] * o[1]) + (o[2] * o[2] + o[3] * o[3]);
                        if (a2) { const f32x4 gv = *(const f32x4*)(gvec + col0 + co); u32x2 w; w.x = cvt_pk_bf16(o[0] * gv[0], o[1] * gv[1]); w.y = cvt_pk_bf16(o[2] * gv[2], o[3] * gv[3]);
                            *(u32x2*)(a2 + off + co) = w; } }
                s += __shfl_xor(s, 16); s += __shfl_xor(s, 32);
                if (fq == 0) atomicAdd(ss + row, s); }
        return false;
    }
};
struct EpiFinal {
    static constexpr bool PERM = false;
    const float* base; float* out; const float* gvec; float* ss; unsigned* cnt;
    __device__ __forceinline__ bool operator()(f32x4 (&acc)[2][2][4][2], const Unit& u, int wr, int wc, int fr, int fq) const {
        const int row0 = u.pm * BM + wr * 64 + fr, col0 = u.pn * BM + wc * 32 + 4 * fq;
#pragma unroll
        for (int ai = 0; ai < 2; ++ai)
#pragma unroll
            for (int m = 0; m < 4; ++m) { const int row = row0 + ai * HALF + m * 16; const size_t off = (size_t)row * DM + col0; float s = 0.f;
#pragma unroll
                for (int bj = 0; bj < 2; ++bj)
#pragma unroll
                    for (int n = 0; n < 2; ++n) { const int co = bj * HALF + n * 16;
                        const f32x4 bs = *(const f32x4*)(base + off + co); const f32x4 o = bs + acc[ai][bj][m][n]; acc[ai][bj][m][n] = o;
                        s += (o[0] * o[0] + o[1] * o[1]) + (o[2] * o[2] + o[3] * o[3]); }
                s += __shfl_xor(s, 16); s += __shfl_xor(s, 32);
                if (fq == 0) atomicAdd(ss + row, s); }
        asm volatile("s_waitcnt vmcnt(0)" ::: "memory");
        unsigned* cw = cnt + 64 * u.pm;
        if ((threadIdx.x & 63) == 0) __hip_atomic_fetch_add(cw, 1u, __ATOMIC_RELAXED, __HIP_MEMORY_SCOPE_AGENT);
        { unsigned sp = 0; while ((unsigned)__builtin_amdgcn_readfirstlane((int)__hip_atomic_load(cw, __ATOMIC_RELAXED, __HIP_MEMORY_SCOPE_AGENT)) < 64u) { __builtin_amdgcn_s_sleep(2); if (++sp > (1u << 22)) break; } }
        __builtin_amdgcn_fence(__ATOMIC_ACQUIRE, "agent");
#pragma unroll
        for (int ai = 0; ai < 2; ++ai)
#pragma unroll
            for (int m = 0; m < 4; ++m) { const int row = row0 + ai * HALF + m * 16; const size_t off = (size_t)row * DM + col0;
                const float rstd = rsqrtf(__hip_atomic_load(ss + row, __ATOMIC_RELAXED, __HIP_MEMORY_SCOPE_AGENT) * (1.f / DM) + EPS);
#pragma unroll
                for (int bj = 0; bj < 2; ++bj)
#pragma unroll
                    for (int n = 0; n < 2; ++n) { const int co = bj * HALF + n * 16; const f32x4 gv = *(const f32x4*)(gvec + col0 + co);
                        f32x4 o = acc[ai][bj][m][n] * rstd; o[0] *= gv[0]; o[1] *= gv[1]; o[2] *= gv[2]; o[3] *= gv[3];
                        *(f32x4*)(out + off + co) = o; } }
        return false;
    }
};
struct EpiUp {
    static constexpr bool PERM = true;
    const float* ss; bf16_t* hid;
    __device__ __forceinline__ bool operator()(f32x4 (&acc)[2][2][4][2], const Unit& u, int wr, int wc, int fr, int fq) const {
        const int row0 = u.pm * BM + wr * 64 + fr, col0 = u.pn * BM + wc * 32 + 8 * fq;
#pragma unroll
        for (int ai = 0; ai < 2; ++ai)
#pragma unroll
            for (int m = 0; m < 4; ++m) { const int row = row0 + ai * HALF + m * 16; const float rstd = rsqrtf(ss[row] * (1.f / DM) + EPS);
                bf16_t* rowp = hid + (size_t)row * DFF + col0;
#pragma unroll
                for (int bj = 0; bj < 2; ++bj) { f32x4 v0 = acc[ai][bj][m][0] * rstd, v1 = acc[ai][bj][m][1] * rstd;
#pragma unroll
                    for (int e = 0; e < 4; ++e) { const float a = fmaxf(v0[e], 0.f), b = fmaxf(v1[e], 0.f); v0[e] = a * a; v1[e] = b * b; }
                    u32x4 w; w.x = cvt_pk_bf16(v0[0], v0[1]); w.y = cvt_pk_bf16(v0[2], v0[3]); w.z = cvt_pk_bf16(v1[0], v1[1]); w.w = cvt_pk_bf16(v1[2], v1[3]);
                    *(u32x4*)(rowp + bj * HALF) = w; } }
        return false;
    }
};
}

namespace fox {
DI int ftid() { int t = threadIdx.x; asm volatile("" : "+v"(t)); return t; }
constexpr int D = 128, QS = DM, KS = DM, VS = DM, OS = DM;
constexpr float SCALE = 0.08838834764831845f, THR = 8.f;
constexpr int NW = 8, QBLK = 32, KVBLK = 64, QB = NW * QBLK;
constexpr int SHM_V = KVBLK * D * 2, SHM_K = KVBLK * D * 2;
constexpr int OFF_WS = 2 * SHM_V + 2 * SHM_K;
constexpr int OFF_BIAS = OFF_WS + NW * 64 * 4;
constexpr int BIAS_BYTES = LP * 4;
static_assert(OFF_BIAS + 2 * BIAS_BYTES <= RING_BYTES, "fox lds");
#define KSWZ(row, colB) ((row) * 256 + ((colB) ^ (((row) & 7) << 4)))
#define SBAR() __builtin_amdgcn_sched_barrier(0)
DI int v_st(int k, int c) { const int kk = (k & ~0xC) | ((k & 4) << 1) | ((k & 8) >> 1); return ((kk >> 3) * 4 + (c >> 5)) * 512 + ((kk & 7) * 32 + (c & 31)) * 2; }
DI int v_rd_base(int lane) { return ((lane & 3) << 3) | (((lane >> 2) & 3) << 6) | (((lane >> 4) & 1) << 5) | (((lane >> 5) & 1) << 8); }
constexpr int v_rd_off(int d0, int ks, int half) { return d0 * 512 + ks * 4096 + half * 2048; }
DI int crow(int r, int hi) { return (r & 3) + 8 * (r >> 2) + 4 * hi; }
DI bf16x8 load8(const bf16_t* p) { return *reinterpret_cast<const bf16x8*>(p); }
DI void mask_tile(f32x16& p0, f32x16& p1, int dq, unsigned W) {
    const float NEG = -__builtin_inff();
#pragma unroll
    for (int r = 0; r < 16; ++r) {
        const int c = (r & 3) + 8 * (r >> 2);
        if ((unsigned)(dq - c) >= W) p0[r] = NEG;
        if ((unsigned)(dq - c - 32) >= W) p1[r] = NEG;
    }
}
DI void partialSM(f32x16& p0, f32x16& p1, float& m_reg, float& mn, float& alpha) {
    float pmax = p0[0]; for (int r = 1; r < 16; ++r) pmax = fmaxf(pmax, p0[r]); for (int r = 0; r < 16; ++r) pmax = fmaxf(pmax, p1[r]);
    { auto rr = __builtin_amdgcn_permlane32_swap(__float_as_uint(pmax), __float_as_uint(pmax), false, false);
      pmax = fmaxf(__uint_as_float(rr[0]), __uint_as_float(rr[1])); }
    constexpr float C2 = 1.4426950408889634f * SCALE;
    if (__builtin_expect(__all((pmax - m_reg) * SCALE <= THR), 1)) { mn = m_reg; alpha = 1.f; }
    else { mn = fmaxf(m_reg, pmax); alpha = __builtin_amdgcn_exp2f((m_reg - mn) * C2); m_reg = mn; }
    const float mnL = -mn * C2;
    for (int r = 0; r < 16; ++r) p0[r] = fmaf(p0[r], C2, mnL); for (int r = 0; r < 16; ++r) p1[r] = fmaf(p1[r], C2, mnL);
    for (int r = 0; r < 16; ++r) p0[r] = __builtin_amdgcn_exp2f(p0[r]);
}
DI void finishSM(f32x16& p0, f32x16& p1, float alpha, float& l_reg, bf16x8& pa0, bf16x8& pa1, bf16x8& pa2, bf16x8& pa3) {
    for (int r = 0; r < 16; ++r) p1[r] = __builtin_amdgcn_exp2f(p1[r]);
    float ps = 0; for (int r = 0; r < 16; ++r) ps += p0[r]; for (int r = 0; r < 16; ++r) ps += p1[r];
    { auto rr = __builtin_amdgcn_permlane32_swap(__float_as_uint(ps), __float_as_uint(ps), false, false);
      ps = __uint_as_float(rr[0]) + __uint_as_float(rr[1]); }
    l_reg = l_reg * alpha + ps;
#define PK4(P, B_, OUT) do { unsigned a0 = cvt_pk_bf16(P[B_+0], P[B_+1]), a1 = cvt_pk_bf16(P[B_+2], P[B_+3]);                          \
        unsigned b0 = cvt_pk_bf16(P[B_+4], P[B_+5]), b1 = cvt_pk_bf16(P[B_+6], P[B_+7]);                                             \
        auto r0 = __builtin_amdgcn_permlane32_swap(a0, b0, false, false); auto r1 = __builtin_amdgcn_permlane32_swap(a1, b1, false, false); \
        u32x4 w = {r0[0], r1[0], r0[1], r1[1]}; OUT = *reinterpret_cast<bf16x8*>(&w); } while (0)
    PK4(p0, 0, pa0); PK4(p0, 8, pa1); PK4(p1, 0, pa2); PK4(p1, 8, pa3);
#undef PK4
}
template <int KB>
DI void qkt(f32x16& p0, f32x16& p1, const char* K_lds, const char* bias_t, int r32_in, int hi_in, const bf16x8* qr) {
    int l_ = threadIdx.x; asm volatile("" : "+v"(l_)); const int r32 = l_ & 31, hi = (l_ >> 5) & 1;
    { const char* bp = bias_t + 16 * hi;
#pragma unroll
      for (int gq = 0; gq < 4; ++gq) { const f32x4 a = *(const f32x4*)(bp + 32 * gq); const f32x4 b = *(const f32x4*)(bp + 128 + 32 * gq);
          p0[4 * gq] = a[0]; p0[4 * gq + 1] = a[1]; p0[4 * gq + 2] = a[2]; p0[4 * gq + 3] = a[3];
          p1[4 * gq] = b[0]; p1[4 * gq + 1] = b[1]; p1[4 * gq + 2] = b[2]; p1[4 * gq + 3] = b[3]; } }
    const char* kb[4];
#pragma unroll
    for (int dd = 0; dd < 4; ++dd) kb[dd] = K_lds + KB * SHM_K + KSWZ(r32, (dd * 16 + hi * 8) * 2);
#pragma unroll
    for (int d0 = 0; d0 < 8; ++d0) { const char* a = kb[d0 & 3] + (d0 >> 2) * 128;
        bf16x8 b0 = *reinterpret_cast<const bf16x8*>(a);
        bf16x8 b1 = *reinterpret_cast<const bf16x8*>(a + 32 * 256);
        p0 = __builtin_amdgcn_mfma_f32_32x32x16_bf16(b0, qr[d0], p0, 0, 0, 0);
        p1 = __builtin_amdgcn_mfma_f32_32x32x16_bf16(b1, qr[d0], p1, 0, 0, 0); }
}
template <int VB>
DI void pv_tile(f32x16* o, int vb0, bf16x8 pa0, bf16x8 pa1, bf16x8 pa2, bf16x8 pa3) {
#define TRRD(dst, off) asm volatile("ds_read_b64_tr_b16 %0, %1 offset:%2" : "=&v"(dst) : "v"(vb0), "i"(off) : "memory")
#define PV_D0(d0) do { s16x4 l0, l1, l2, l3, h0, h1, h2, h3; constexpr int b_ = VB * SHM_V + v_rd_off(d0, 0, 0); \
        TRRD(l0, b_); TRRD(h0, b_ + 2048); TRRD(l1, b_ + 4096); TRRD(h1, b_ + 6144); TRRD(l2, b_ + 8192); TRRD(h2, b_ + 10240); TRRD(l3, b_ + 12288); TRRD(h3, b_ + 14336); \
        asm volatile("s_waitcnt lgkmcnt(0)" ::: "memory"); SBAR();   \
        o[d0] = __builtin_amdgcn_mfma_f32_32x32x16_bf16(pa0, (bf16x8){l0[0], l0[1], l0[2], l0[3], h0[0], h0[1], h0[2], h0[3]}, o[d0], 0, 0, 0);   \
        o[d0] = __builtin_amdgcn_mfma_f32_32x32x16_bf16(pa1, (bf16x8){l1[0], l1[1], l1[2], l1[3], h1[0], h1[1], h1[2], h1[3]}, o[d0], 0, 0, 0);   \
        o[d0] = __builtin_amdgcn_mfma_f32_32x32x16_bf16(pa2, (bf16x8){l2[0], l2[1], l2[2], l2[3], h2[0], h2[1], h2[2], h2[3]}, o[d0], 0, 0, 0);   \
        o[d0] = __builtin_amdgcn_mfma_f32_32x32x16_bf16(pa3, (bf16x8){l3[0], l3[1], l3[2], l3[3], h3[0], h3[1], h3[2], h3[3]}, o[d0], 0, 0, 0); } while (0)
    PV_D0(0); PV_D0(1); PV_D0(2); PV_D0(3);
#undef PV_D0
#undef TRRD
}
struct BlockRef { const bf16_t* Q; const bf16_t* K; const bf16_t* V; bf16_t* O; const float* bias; int P0; };
struct Seam { bf16x8 qr[8]; bf16x8 st_v0, st_v1, st_k0, st_k1; };
#define LAUNDER(v) asm volatile("" : "+v"(v))
#define VMW() asm volatile("s_waitcnt vmcnt(0)" ::: "memory")
#define SLOAD_H(Kp, Vp, k0) do { int t_ = threadIdx.x; LAUNDER(t_); const int sr_ = t_ >> 4, sc_ = (t_ & 15) * 8;                   \
        const bf16_t* kp_ = (Kp) + (size_t)(k0) * KS; const bf16_t* vp_ = (Vp) + (size_t)(k0) * VS;                                 \
        const unsigned ok_ = (unsigned)(sr_ * KS + sc_), ov_ = (unsigned)(sr_ * VS + sc_);                                          \
        S.st_v0 = load8(vp_ + ov_); S.st_v1 = load8(vp_ + ov_ + 32 * VS); S.st_k0 = load8(kp_ + ok_); S.st_k1 = load8(kp_ + ok_ + 32 * KS); } while (0)
#define SWRITE_HK(bf) do { int t_ = threadIdx.x; LAUNDER(t_); const int sr_ = t_ >> 4, sc_ = (t_ & 15) * 8, kws_ = KSWZ(sr_, sc_ * 2);     \
        *(bf16x8*)(K_lds + (bf) * SHM_K + kws_) = S.st_k0; *(bf16x8*)(K_lds + (bf) * SHM_K + kws_ + 32 * 256) = S.st_k1; } while (0)
#define SWRITE_HV(bf) do { int t_ = threadIdx.x; LAUNDER(t_); const int sr_ = t_ >> 4, sc_ = (t_ & 15) * 8;                               \
        *(bf16x8*)(V_lds + (bf) * SHM_V + v_st(sr_, sc_)) = S.st_v0; *(bf16x8*)(V_lds + (bf) * SHM_V + v_st(32 + sr_, sc_)) = S.st_v1; } while (0)
#define SWRITE_H(bf) do { SWRITE_HV(bf); SWRITE_HK(bf); } while (0)
DI void bias_stage(const float* bias, char* lds, int par) {
    const int tid = ftid(), wid = __builtin_amdgcn_readfirstlane(tid >> 6);
    LAS unsigned char* dst = (LAS unsigned char*)lds + OFF_BIAS + par * BIAS_BYTES + wid * 1024;
    __builtin_amdgcn_global_load_lds((const unsigned*)(bias + tid * 4), (LAS unsigned*)dst, 16, 0, 0);
    __builtin_amdgcn_global_load_lds((const unsigned*)(bias + 2048 + tid * 4), (LAS unsigned*)(dst + 8192), 16, 0, 0);
    if (tid < 16) __builtin_amdgcn_global_load_lds((const unsigned*)(bias + 4096 + tid * 4), (LAS unsigned*)(dst + 16384), 16, 0, 0);
}
DI void causal_prime(const BlockRef& cur, char* lds, Seam& S, int par) {
    const int tid = ftid(), wid = __builtin_amdgcn_readfirstlane(tid >> 6), lane = tid & 63, r32 = lane & 31, hi = lane >> 5;
    char* K_lds = lds + 2 * SHM_V;
    bias_stage(cur.bias, lds, par);
    for (int d0 = 0; d0 < 8; ++d0) S.qr[d0] = load8(cur.Q + (unsigned)((wid * QBLK + r32) * QS + d0 * 16 + hi * 8));
    SLOAD_H(cur.K, cur.V, 0); VMW(); SWRITE_HK(0);
    __syncthreads();
}
DI void causal_block(const BlockRef& cur, const BlockRef& nxt, char* lds, Seam& S, int par) {
    const int tid = ftid(), wid = __builtin_amdgcn_readfirstlane(tid >> 6), lane = tid & 63, r32 = lane & 31, hi = lane >> 5;
    constexpr unsigned W = 1u << 30;
    const int NT = (cur.P0 + QB - 1) / KVBLK + 1;
    const int qlo = cur.P0 + wid * QBLK, qm = qlo + r32 - 4 * hi;
    char* V_lds = lds; char* K_lds = lds + 2 * SHM_V;
    float* ws = (float*)(lds + OFF_WS) + wid * 64; float* li_l = ws, * al_l = ws + 32;
    const char* bias_l = lds + OFF_BIAS + par * BIAS_BYTES;
    float m_reg = -1e30f, l_reg = 0; f32x16 o[4] = {};
    const int vb0 = (int)(uintptr_t)V_lds + v_rd_base(lane);
    const bf16_t* Kh = cur.K; const bf16_t* Vh = cur.V;
#define RESC(a) do { if (__any((a) < 1.f)) { if (hi == 0) al_l[r32] = (a); asm volatile("s_waitcnt lgkmcnt(0)" ::: "memory");              \
                     for (int d_ = 0; d_ < 4; ++d_) for (int r = 0; r < 16; ++r) o[d_][r] *= al_l[crow(r, hi)]; } } while (0)
#define KBASE(t) ((t) * KVBLK)
#define MASKT(P0_, P1_, t) do { const int kb_ = KBASE(t); if (kb_ + KVBLK - 1 > qlo) mask_tile(P0_, P1_, qm - kb_, W); } while (0)
#define BIAST(t) (bias_l + (t) * (KVBLK * 4))
    f32x16 pA0, pA1, pB0, pB1; float mnA, mnB, alA, alB; bf16x8 pa0, pa1, pa2, pa3;
    SWRITE_HV(0); SBAR();
    if (NT > 1) { SLOAD_H(Kh, Vh, KBASE(1)); }
    SBAR(); qkt<0>(pA0, pA1, K_lds, BIAST(0), r32, hi, S.qr);
    MASKT(pA0, pA1, 0); partialSM(pA0, pA1, m_reg, mnA, alA);
    if (NT > 1) { VMW(); SWRITE_H(1); }
    __syncthreads();
#define HALF_STEP(PX0, PX1, mnX, alX, PY0, PY1, alY, t, KB, VB, SB) do {                                                      \
        SBAR(); qkt<KB>(PX0, PX1, K_lds, BIAST(t), r32, hi, S.qr);                                             \
        finishSM(PY0, PY1, alY, l_reg, pa0, pa1, pa2, pa3); SBAR();                                                           \
        if ((t) + 1 < NT) { SLOAD_H(Kh, Vh, KBASE((t) + 1)); SBAR(); }                                               \
        pv_tile<VB>(o, vb0, pa0, pa1, pa2, pa3); MASKT(PX0, PX1, (t)); partialSM(PX0, PX1, m_reg, mnX, alX);                                        \
        __syncthreads();                                                                                                      \
        if ((t) + 1 < NT) { VMW(); SWRITE_H(SB); }                                                                          \
        RESC(alX); __syncthreads(); } while (0)
    for (int t = 1; t + 1 < NT; t += 2) {
        HALF_STEP(pB0, pB1, mnB, alB, pA0, pA1, alA, t, 1, 0, 0);
        HALF_STEP(pA0, pA1, mnA, alA, pB0, pB1, alB, t + 1, 0, 1, 1);
    }
    const bool even = (NT & 1) == 0;
    if (even) { SBAR(); qkt<1>(pB0, pB1, K_lds, BIAST(NT - 1), r32, hi, S.qr); SBAR(); }
    bias_stage(nxt.bias, lds, par ^ 1); SBAR();
    SLOAD_H(nxt.K, nxt.V, 0); SBAR();
#pragma unroll
    for (int d0 = 0; d0 < 8; ++d0) S.qr[d0] = load8(nxt.Q + (unsigned)((wid * QBLK + r32) * QS + d0 * 16 + hi * 8));
    SBAR();
    finishSM(pA0, pA1, alA, l_reg, pa0, pa1, pa2, pa3); SBAR();
    pv_tile<0>(o, vb0, pa0, pa1, pa2, pa3);
    if (even) { MASKT(pB0, pB1, NT - 1); partialSM(pB0, pB1, m_reg, mnB, alB); __syncthreads(); RESC(alB);
        finishSM(pB0, pB1, alB, l_reg, pa0, pa1, pa2, pa3); SBAR(); pv_tile<1>(o, vb0, pa0, pa1, pa2, pa3); }
    SBAR(); VMW(); SWRITE_HK(0); SBAR();
    if (hi == 0) li_l[r32] = l_reg; asm volatile("s_waitcnt lgkmcnt(0)" ::: "memory");
    float rli[16];
#pragma unroll
    for (int r = 0; r < 16; ++r) rli[r] = __builtin_amdgcn_rcpf(li_l[crow(r, hi)]);
    bf16_t* Ow = cur.O + (unsigned)(wid * QBLK * OS + r32);
#pragma unroll
    for (int r = 0; r < 16; ++r) { const int orow = crow(r, hi);
#pragma unroll
        for (int d0 = 0; d0 < 4; ++d0) { const float v = o[d0][r] * rli[r];
            const float vn = __shfl_xor(v, 1);
            if ((r32 & 1) == 0) *(unsigned*)(Ow + (unsigned)(orow * OS + d0 * 32)) = cvt_pk_bf16(v, vn); } }
    __syncthreads();
#undef RESC
#undef KBASE
#undef MASKT
#undef BIAST
#undef HALF_STEP
}
#undef LAUNDER
#undef VMW
#undef SLOAD_H
#undef SWRITE_HK
#undef SWRITE_HV
#undef SWRITE_H
#undef SBAR
#undef KSWZ
}

struct Args {
    const float *x, *meta, *mix_g, *w_in, *conv_w, *a_log, *dt_bias, *gdn_g, *w_o_gdn, *fox_qg, *fox_kg, *fox_fb, *w_o_fox, *w_out, *mlp_g, *w_up, *w_down, *final_g;
    float* out; unsigned char* ws;
};

DI void p0_transpose_item(const float* W, int K, int ldw, int src_c0, bf16_t* WT, int dst_r0, LAS float* scr, int kb, int nb, int lane) {
    const int k0 = 64 * kb, n0 = 32 * nb;
    const float* src = W + (size_t)(k0 + (lane >> 3)) * ldw + src_c0 + n0 + (lane & 7) * 4;
    f32x4 v[8];
#pragma unroll
    for (int i = 0; i < 8; ++i) v[i] = *(const f32x4*)(src + (size_t)(8 * i) * ldw);
#pragma unroll
    for (int i = 0; i < 8; ++i) { LAS float* d = scr + (8 * i + (lane >> 3)) * 33 + (lane & 7) * 4; d[0] = v[i][0]; d[1] = v[i][1]; d[2] = v[i][2]; d[3] = v[i][3]; }
    asm volatile("s_waitcnt lgkmcnt(0)" ::: "memory");
    const int c = lane & 7;
#pragma unroll
    for (int j = 0; j < 4; ++j) { const int n = (lane >> 3) + 8 * j; const LAS float* s = scr + (8 * c) * 33 + n;
        u32x4 o; o.x = cvt_pk_bf16(s[0 * 33], s[1 * 33]); o.y = cvt_pk_bf16(s[2 * 33], s[3 * 33]); o.z = cvt_pk_bf16(s[4 * 33], s[5 * 33]); o.w = cvt_pk_bf16(s[6 * 33], s[7 * 33]);
        *(u32x4*)(WT + (size_t)(dst_r0 + n0 + n) * K + k0 + 8 * c) = o; }
    asm volatile("s_waitcnt lgkmcnt(0)" ::: "memory");
}
DI void rms_row_to_bf16(const float* xrow, const float* g, bf16_t* orow, int lane) {
    const f32x4* xr = (const f32x4*)xrow + lane; const f32x4* gr = (const f32x4*)g + lane;
    f32x4 v[8]; float s = 0.f;
#pragma unroll
    for (int j = 0; j < 8; ++j) { v[j] = xr[64 * j]; s += (v[j].x * v[j].x + v[j].y * v[j].y) + (v[j].z * v[j].z + v[j].w * v[j].w); }
    const float rstd = rsqrtf(wave_sum(s) * (1.f / DM) + EPS);
    u32x2* o8 = (u32x2*)orow + lane;
#pragma unroll
    for (int j = 0; j < 8; ++j) { const f32x4 gg = gr[64 * j]; u32x2 w; w.x = cvt_pk_bf16(v[j].x * rstd * gg.x, v[j].y * rstd * gg.y); w.y = cvt_pk_bf16(v[j].z * rstd * gg.z, v[j].w * rstd * gg.w); o8[64 * j] = w; }
}
DI float log_sigmoid_(float x) { return fminf(x, 0.f) - log1pf(__expf(-fabsf(x))); }
DI float softplus_(float x) { return fmaxf(x, 0.f) + log1pf(__expf(-fabsf(x))); }
DI bf16x8 ld2x8(const bf16_t* p) { const s16x4 lo = *(const s16x4*)p; const s16x4 hi = *(const s16x4*)(p + 16); return __builtin_shufflevector(lo, hi, 0, 1, 2, 3, 4, 5, 6, 7); }
DI bf16x8 packacc(const f32x4 a, const f32x4 b) { u32x4 w = {cvt_pk_bf16(a[0], a[1]), cvt_pk_bf16(a[2], a[3]), cvt_pk_bf16(b[0], b[1]), cvt_pk_bf16(b[2], b[3])}; return __builtin_bit_cast(bf16x8, w); }
#define MFMA16(a, b, c) __builtin_amdgcn_mfma_f32_16x16x32_bf16((a), (b), (c), 0, 0, 0)
#define MFMA32(a, b, c) __builtin_amdgcn_mfma_f32_32x32x16_bf16((a), (b), (c), 0, 0, 0)

DI void glds16(const void* gsrc, unsigned lds_dst) { unsigned keep;
    asm volatile("s_mov_b32 %0, m0\n\ts_mov_b32 m0, %2\n\ts_nop 0\n\tglobal_load_lds_dwordx4 %1, off\n\ts_mov_b32 m0, %0" : "=&s"(keep) : "v"(gsrc), "s"(lds_dst) : "memory"); }

#define XB_TMO      128
#define XB_XCNT(j)  (256  + 64 * (j))
#define XB_XSUB(j)  (1280 + 64 * (j))
#define XB_XGEN(j)  (2304 + 64 * (j))
#define XB_TOP      3328
#define XB_TOPGEN   3392
#define XCD_BAR_WORDS 3456
#define XB_SPIN_CAP (1u << 18)
DI unsigned xb_ld(unsigned* p)              { return __hip_atomic_load(p, __ATOMIC_RELAXED, __HIP_MEMORY_SCOPE_AGENT); }
DI unsigned xb_add(unsigned* p, unsigned v) { return __hip_atomic_fetch_add(p, v, __ATOMIC_RELAXED, __HIP_MEMORY_SCOPE_AGENT); }
DI unsigned xb_xcc_id() { return (unsigned)__builtin_amdgcn_s_getreg((3 << 11) | 20) & 0xFu; }
#define XB_SPIN(cond, bar) do { unsigned _sp = 0; while (cond) { __builtin_amdgcn_s_sleep(1); \
    if ((++_sp & 255u) == 0u) { if (xb_ld(&(bar)[XB_TMO])) break; if (_sp > XB_SPIN_CAP) { atomicAdd(&(bar)[XB_TMO], 1u); break; } } } } while (0)
struct XcdBarrier { unsigned* bar; unsigned x; volatile LAS unsigned* st; };
DI XcdBarrier xcd_barrier_post(unsigned* bar, volatile LAS unsigned* st) {
    XcdBarrier b; b.bar = bar; b.x = xb_xcc_id(); b.st = st;
    if (threadIdx.x == 0) (void)xb_add(&bar[XB_XCNT(b.x)], 1u);
    return b;
}
DI void xcd_barrier_complete(unsigned* bar, unsigned x, unsigned& nloc, unsigned& nx) {
    const unsigned G = gridDim.x * gridDim.y * gridDim.z;
    unsigned sum, cnt, mine, sp = 0u;
    for (;;) {
        sum = 0u; cnt = 0u; mine = 0u;
#pragma unroll
        for (unsigned j = 0; j < 16; ++j) { const unsigned c = xb_ld(&bar[XB_XCNT(j)]); sum += c; cnt += (c > 0u) ? 1u : 0u; mine = (j == x) ? c : mine; }
        if (sum == G) break;
        __builtin_amdgcn_s_sleep(1);
        if ((++sp & 255u) == 0u) { if (xb_ld(&bar[XB_TMO])) break; if (sp > XB_SPIN_CAP) { atomicAdd(&bar[XB_TMO], 1u); break; } }
    }
    nloc = mine > 0u ? mine : 1u; nx = cnt > 0u ? cnt : 1u;
}
DI void xcd_barrier(const XcdBarrier& b) {
    asm volatile("s_waitcnt vmcnt(0)" ::: "memory");
    __syncthreads();
    if (threadIdx.x == 0) {
        unsigned* bar = b.bar;
        __builtin_amdgcn_s_waitcnt(0);
        unsigned nloc = b.st[0], nx = b.st[1];
        if (nloc == 0u) { xcd_barrier_complete(bar, b.x, nloc, nx); b.st[0] = nloc; b.st[1] = nx; }
        const unsigned old = xb_add(&bar[XB_XSUB(b.x)], 1u);
        const unsigned gen = old / nloc;
        if (old + 1u == (gen + 1u) * nloc) {
            __builtin_amdgcn_fence(__ATOMIC_RELEASE, "agent");
            asm volatile("s_waitcnt vmcnt(0)" ::: "memory");
            const unsigned og = xb_add(&bar[XB_TOP], 1u);
            const unsigned tg = og / nx;
            if (og + 1u == (tg + 1u) * nx) xb_add(&bar[XB_TOPGEN], 1u);
            else XB_SPIN(xb_ld(&bar[XB_TOPGEN]) == tg, bar);
            __builtin_amdgcn_fence(__ATOMIC_ACQUIRE, "agent");
            asm volatile("s_waitcnt vmcnt(0)" ::: "memory");
        } else {
            XB_SPIN(xb_ld(&bar[XB_TOPGEN]) == gen, bar);
            __builtin_amdgcn_fence(__ATOMIC_ACQUIRE, "agent");
            asm volatile("s_waitcnt vmcnt(0)" ::: "memory");
        }
    }
    __syncthreads();
}
typedef const __attribute__((address_space(4))) Args CArgs;
#define PH_BEGIN \
    CArgs* ap = (CArgs*)__builtin_amdgcn_kernarg_segment_ptr(); asm volatile("" : "+s"(ap)); \
    int tid = threadIdx.x; asm volatile("" : "+v"(tid)); \
    const int lane = tid & 63, wave = __builtin_amdgcn_readfirstlane(tid >> 6); \
    const int G = gridDim.x, bx = blockIdx.x, gw = bx * 8 + wave, NGW = G * 8; \
    unsigned char* ws = ap->ws; LAS unsigned char* ldsl = (LAS unsigned char*)lds; \
    (void)lane; (void)wave; (void)gw; (void)NGW; (void)ws; (void)ldsl;
#define WSP(T, off) ((T*)(ws + (off)))

__global__ void __launch_bounds__(512) mk_fwd(Args args_unused) {
    extern __shared__ __attribute__((aligned(16))) unsigned char lds[];
    cg::grid_group grid = cg::this_grid();
    if (threadIdx.x < 64) ((LAS unsigned*)((LAS unsigned char*)lds + MISC_OFF))[threadIdx.x] = 0u;
    __syncthreads();
    const XcdBarrier xbar = xcd_barrier_post((unsigned*)(((CArgs*)__builtin_amdgcn_kernarg_segment_ptr())->ws + O_CTL) + CW_BAR, (volatile LAS unsigned*)((LAS unsigned char*)lds + MISC_OFF) + 8);
    {
        PH_BEGIN
        bf16_t* WTIN = WSP(bf16_t, O_WTIN); bf16_t* U = WSP(bf16_t, O_U); bf16_t* WOG = WSP(bf16_t, O_WOG); bf16_t* WOF = WSP(bf16_t, O_WOF); bf16_t* WOUT = WSP(bf16_t, O_WOUT); bf16_t* WUP = WSP(bf16_t, O_WUP); bf16_t* WDN = WSP(bf16_t, O_WDN);
        LAS float* scr = (LAS float*)(ldsl + wave * 16384);
        constexpr int I_IN = 32 * (NBIG / 32);
        for (int it = gw; it < I_IN; it += NGW) {
            const int nbk = NBIG / 32, kb = it / nbk, nb = it % nbk; const int dr = nb * 32; int sc;
            if (dr < 6144) sc = dr; else if (dr < 8192) sc = dr; else if (dr < 14336) sc = dr - 8192 + 8224; else if (dr < 16384) sc = dr - 14336 + 14384; else sc = dr - 16384 + 16432;
            p0_transpose_item(ap->w_in, DM, NIN, sc, WTIN, dr, scr, kb, 0, lane);
        }
        for (int e = bx * 512 + tid; e < 64 * DM; e += G * 512) { const int j = e / DM, k = e % DM; float v = 0.f;
            if (j < 48) { const int sc = j < 16 ? 8192 + j : (j < 32 ? 8208 + (j - 16) : 14368 + (j - 32)); v = ap->w_in[(size_t)k * NIN + sc]; }
            WTIN[(size_t)(NBIG + j) * DM + k] = f2bf(v); }
        for (int m = gw; m < MX + NMETA; m += NGW) rms_row_to_bf16(m < MX ? ap->x + (size_t)m * DM : ap->meta + (size_t)(m - MX) * DM, ap->mix_g, U + (size_t)m * DM, lane);
    }
    grid.sync();

    {
        PH_BEGIN
        bf16_t* WTIN = WSP(bf16_t, O_WTIN); bf16_t* U = WSP(bf16_t, O_U); bf16_t* GRAW = WSP(bf16_t, O_GRAW); bf16_t* FQN = WSP(bf16_t, O_FQN); bf16_t* FKN = WSP(bf16_t, O_FKN); bf16_t* FVN = WSP(bf16_t, O_FVN); bf16_t* Z = WSP(bf16_t, O_Z); bf16_t* GA = WSP(bf16_t, O_GA); bf16_t* GB = WSP(bf16_t, O_GB); float* SM = WSP(float, O_SM);
        pg8::Gemm g{U, WTIN, MX, NBIG, DM, 1 << 30, 0}; pg8::StaticOrder S; S.init(MX, NBIG, G, bx);
        pg8::EpiIn E{GRAW, Z, FQN, FKN, FVN, GA, GB, ap->fox_qg, ap->fox_kg, (LAS float*)(ldsl + RING_BYTES)};
        pg8::gemm_phase<pg8::EpiIn, pg8::StaticOrder>(ldsl, g, S, E);
        const int m16 = lane & 15, g4 = lane >> 4;
        constexpr int T_META = 384 + 384 + 3, T_SMALL = MX / 16;
        const int gwm = wave * G + bx;
        for (int t = gwm; t < T_META + T_SMALL; t += NGW) {
            if (t < T_META) {
                int wrow, dcol; int kind;
                if (t < 384) { wrow = 16 * t; dcol = 16 * t; kind = 0; } else if (t < 768) { wrow = 8192 + 16 * (t - 384); dcol = 16 * (t - 384); kind = 1; } else { wrow = NBIG + 16 * (t - 768); dcol = 16 * (t - 768); kind = 2; }
                const bf16_t* ap = U + (size_t)(MX + m16) * DM + 8 * g4; const bf16_t* bp = WTIN + (size_t)(wrow + m16) * DM + 8 * g4;
                f32x4 acc = {0.f, 0.f, 0.f, 0.f};
                f32x4 accb = {0.f, 0.f, 0.f, 0.f};
#pragma unroll 8
                for (int kk = 0; kk < DM / 32; kk += 2) { acc = MFMA16(*(const bf16x8*)(ap + 32 * kk), *(const bf16x8*)(bp + 32 * kk), acc);
                    accb = MFMA16(*(const bf16x8*)(ap + 32 * kk + 32), *(const bf16x8*)(bp + 32 * kk + 32), accb); }
                acc += accb;
#pragma unroll
                for (int r = 0; r < 4; ++r) { const int mt = 4 * g4 + r;
#pragma unroll
                    for (int b = 0; b < NB; ++b) { const size_t rp = (size_t)b * LP + PADF + mt;
                        if (kind == 0) GRAW[rp * 6144 + dcol + m16] = f2bf(acc[r]); else if (kind == 1) { if (dcol >= 4096) FVN[rp * DM + dcol - 4096 + m16] = f2bf(acc[r]); else if (dcol >= 2048) FKN[rp * DM + dcol - 2048 + m16] = f2bf(acc[r]);   } else SM[rp * NSM + dcol + m16] = acc[r]; } }
            } else {
                const int rt = t - T_META;
                const bf16_t* ap = U + (size_t)(16 * rt + m16) * DM + 8 * g4; const bf16_t* bp = WTIN + (size_t)(NBIG + m16) * DM + 8 * g4;
                f32x4 a0 = {0.f, 0.f, 0.f, 0.f}, a1 = a0, a2 = a0;
#pragma unroll 8
                for (int kk = 0; kk < DM / 32; ++kk) { const bf16x8 av = *(const bf16x8*)(ap + 32 * kk);
                    a0 = MFMA16(av, *(const bf16x8*)(bp + 32 * kk), a0); a1 = MFMA16(av, *(const bf16x8*)(bp + 16 * DM + 32 * kk), a1); a2 = MFMA16(av, *(const bf16x8*)(bp + 32 * DM + 32 * kk), a2); }
#pragma unroll
                for (int r = 0; r < 4; ++r) { const int m = 16 * rt + 4 * g4 + r; const size_t rp = (size_t)m + XOFF + 64 * (m >> 12);
                    SM[rp * NSM + m16] = a0[r]; SM[rp * NSM + 16 + m16] = a1[r]; SM[rp * NSM + 32 + m16] = a2[r]; }
            }
        }
    }
    xcd_barrier(xbar);

    {
        PH_BEGIN
        bf16_t* GRAW = WSP(bf16_t, O_GRAW); bf16_t* FVN = WSP(bf16_t, O_FVN); bf16_t* GQN = WSP(bf16_t, O_GQN); bf16_t* GKN = WSP(bf16_t, O_GKN); bf16_t* GVN = WSP(bf16_t, O_GVN); bf16_t* FQN = WSP(bf16_t, O_FQN); bf16_t* FKN = WSP(bf16_t, O_FKN);
        float* SM = WSP(float, O_SM); float* BETA = WSP(float, O_BETA); float* GG = WSP(float, O_GG); float* FB = WSP(float, O_FB);
        const float QSC = 0.08838834764831845f;
#define LDROW(tp_) (((tp_) >= PADF) ? *(const u32x4*)(src + (size_t)(tp_) * 6144) : (u32x4){0u, 0u, 0u, 0u})
#define UNPK(dstf, u) do { dstf[0] = __uint_as_float(u.x << 16); dstf[1] = __uint_as_float(u.x & 0xffff0000u); dstf[2] = __uint_as_float(u.y << 16); dstf[3] = __uint_as_float(u.y & 0xffff0000u); \
                           dstf[4] = __uint_as_float(u.z << 16); dstf[5] = __uint_as_float(u.z & 0xffff0000u); dstf[6] = __uint_as_float(u.w << 16); dstf[7] = __uint_as_float(u.w & 0xffff0000u); } while (0)
        for (int it = gw; it < 640 * 12; it += NGW) {
            const int strip = it / 12, cgp = it % 12; const int b = strip / 320, tp0 = (strip % 320) * 13;
            const int ch0 = cgp * 512 + lane * 8;
            float cw[4][8];
#pragma unroll
            for (int k = 0; k < 4; ++k) { const f32x4 a = *(const f32x4*)(ap->conv_w + k * 6144 + ch0), c = *(const f32x4*)(ap->conv_w + k * 6144 + ch0 + 4);
                cw[k][0] = a[0]; cw[k][1] = a[1]; cw[k][2] = a[2]; cw[k][3] = a[3]; cw[k][4] = c[0]; cw[k][5] = c[1]; cw[k][6] = c[2]; cw[k][7] = c[3]; }
            const bf16_t* src = GRAW + (size_t)b * LP * 6144 + ch0;
            bf16_t* dst = (cgp < 4 ? GQN : (cgp < 8 ? GKN : GVN)) + (size_t)b * LP * DM + (cgp & 3) * 512 + lane * 8;
            u32x4 ur[16];
#pragma unroll
            for (int i = 0; i < 16; ++i) ur[i] = LDROW(tp0 - 3 + i);
            float x0[8], x1[8], x2[8];
            UNPK(x0, ur[0]); UNPK(x1, ur[1]); UNPK(x2, ur[2]);
#pragma unroll
            for (int i = 0; i < 13; ++i) { const int tp = tp0 + i; float x3[8], y[8]; UNPK(x3, ur[3 + i]); float ssq = 0.f;
#pragma unroll
                for (int e = 0; e < 8; ++e) { const float c = cw[0][e] * x0[e] + cw[1][e] * x1[e] + cw[2][e] * x2[e] + cw[3][e] * x3[e]; y[e] = c * __builtin_amdgcn_rcpf(1.f + __expf(-c)); ssq += y[e] * y[e]; }
                if (cgp < 8) { ssq = sum16(ssq);
                    const float sc = rsqrtf(ssq + EPS) * (cgp < 4 ? QSC : 1.f);
#pragma unroll
                    for (int e = 0; e < 8; ++e) y[e] *= sc; }
                u32x4 w; w.x = cvt_pk_bf16(y[0], y[1]); w.y = cvt_pk_bf16(y[2], y[3]); w.z = cvt_pk_bf16(y[4], y[5]); w.w = cvt_pk_bf16(y[6], y[7]);
                *(u32x4*)(dst + (size_t)tp * DM) = w;
#pragma unroll
                for (int e = 0; e < 8; ++e) { x0[e] = x1[e]; x1[e] = x2[e]; x2[e] = x3[e]; } }
        }
        for (int it = gw; it < NB * XOFF; it += NGW) {
            const int b = it / XOFF, tp = it % XOFF; const size_t rp = (size_t)b * LP + tp;
            bf16_t* kd = FKN + rp * DM + lane * 32;
            if (tp < PADF) { bf16_t* vd = FVN + rp * DM + lane * 32;
#pragma unroll
                for (int i = 0; i < 4; ++i) { *(u32x4*)(kd + 8 * i) = (u32x4){0u, 0u, 0u, 0u}; *(u32x4*)(vd + 8 * i) = (u32x4){0u, 0u, 0u, 0u}; }
                continue; }
            const float* gp = ap->fox_kg + (lane & 3) * 32;
            float v[32]; float ssq = 0.f;
#pragma unroll
            for (int i = 0; i < 4; ++i) { const u32x4 u = *(const u32x4*)(kd + 8 * i); float f[8]; UNPK(f, u);
#pragma unroll
                for (int e = 0; e < 8; ++e) { v[8 * i + e] = f[e]; ssq += f[e] * f[e]; } }
            ssq = sum4(ssq);
            const float rstd = rsqrtf(ssq * (1.f / DH) + EPS);
#pragma unroll
            for (int i = 0; i < 4; ++i) { const f32x4 g0 = *(const f32x4*)(gp + 8 * i), g1 = *(const f32x4*)(gp + 8 * i + 4); u32x4 w;
                w.x = cvt_pk_bf16(v[8 * i] * rstd * g0[0], v[8 * i + 1] * rstd * g0[1]); w.y = cvt_pk_bf16(v[8 * i + 2] * rstd * g0[2], v[8 * i + 3] * rstd * g0[3]);
                w.z = cvt_pk_bf16(v[8 * i + 4] * rstd * g1[0], v[8 * i + 5] * rstd * g1[1]); w.w = cvt_pk_bf16(v[8 * i + 6] * rstd * g1[2], v[8 * i + 7] * rstd * g1[3]);
                *(u32x4*)(kd + 8 * i) = w; }
        }
#undef LDROW
#undef UNPK
        for (int e = bx * 512 + tid; e < NB * NH * LP; e += G * 512) {
            const int bh = e / LP, tp = e % LP, b = bh >> 4, h = bh & 15; float be = 0.f, gg = 0.f;
            if (tp >= PADF) { const float* sm = SM + ((size_t)b * LP + tp) * NSM; be = sigmoidf_(sm[h]); gg = -__expf(ap->a_log[h]) * softplus_(sm[16 + h] + ap->dt_bias[h]); }
            BETA[e] = be; GG[e] = gg; }
        { const int gwm = (NGW == 2048) ? ((gw >= 1536 && ((gw - 1536) & 15) == 0) ? ((gw - 1536) >> 4) : (1 << 20)) : (wave * G + bx);
          for (int bh = gwm; bh < NB * NH; bh += NGW) { const int b = bh >> 4, h = bh & 15; const float fbias = ap->fox_fb[h]; float carry = 0.f;
            float fv[NCH];
#pragma unroll
            for (int i = 0; i < NCH; ++i) { const int tp = i * 64 + lane; fv[i] = (tp >= PADF) ? SM[((size_t)b * LP + tp) * NSM + 32 + h] : 0.f; }
#pragma unroll
            for (int i = 0; i < NCH; ++i) { const int tp = i * 64 + lane; float v = (tp >= PADF) ? log_sigmoid_(fv[i] + fbias) : 0.f;
                v = wave_scan_incl(v);
                const float c = carry + v; carry = __int_as_float(__builtin_amdgcn_readlane(__float_as_int(c), 63));
                FB[(size_t)bh * LP + tp] = (tp >= PADF) ? -c * 11.313708498984761f : -__builtin_inff(); } } }
    }
    xcd_barrier(xbar);

    {
        PH_BEGIN
        bf16_t* GQN = WSP(bf16_t, O_GQN); bf16_t* GKN = WSP(bf16_t, O_GKN); bf16_t* GVN = WSP(bf16_t, O_GVN); bf16_t* WV = WSP(bf16_t, O_WV); bf16_t* WK = WSP(bf16_t, O_WK); bf16_t* KT = WSP(bf16_t, O_KT); bf16_t* QKB = WSP(bf16_t, O_QK);
        float* BETA = WSP(float, O_BETA); float* GG = WSP(float, O_GG); float* GC = WSP(float, O_GC);
        typedef float f32x2 __attribute__((ext_vector_type(2)));
        constexpr int UB = 53248;
        constexpr int NPAIR = NB * NH * NCH / 2;
        bf16_t* WUP = WSP(bf16_t, O_WUP); bf16_t* WDN = WSP(bf16_t, O_WDN); bf16_t* WOG = WSP(bf16_t, O_WOG); bf16_t* WOF = WSP(bf16_t, O_WOF); bf16_t* WOUT = WSP(bf16_t, O_WOUT);
        constexpr int I_UP = 32 * (DFF / 32), I_DN = 128 * (DM / 32), I_SQ = 32 * (DM / 32), NDEF = I_UP + I_DN + 3 * I_SQ;
        const int nslots = (NDEF + G - 1) / G; int dslot = wave - 4;
        LAS float* dscr = (LAS float*)(ldsl + 2 * UB + (wave & 3) * 8448);
#define DEFER_ITEMS(maxn_) do { for (int k_ = 0; k_ < (maxn_) && dslot < nslots; ++k_, dslot += 4) { const int id_ = dslot * G + bx; if (id_ < NDEF) {                       \
                if (id_ < I_UP) p0_transpose_item(ap->w_up, DM, DFF, 0, WUP, 0, dscr, id_ / (DFF / 32), id_ % (DFF / 32), lane);                                                  \
                else if (id_ < I_UP + I_DN) { const int r_ = id_ - I_UP; p0_transpose_item(ap->w_down, DFF, DM, 0, WDN, 0, dscr, r_ / (DM / 32), r_ % (DM / 32), lane); }                 \
                else { const int r_ = id_ - I_UP - I_DN, w_ = r_ / I_SQ, q_ = r_ % I_SQ;                                                                                              \
                    p0_transpose_item(w_ == 0 ? ap->w_o_gdn : (w_ == 1 ? ap->w_o_fox : ap->w_out), DM, DM, 0, w_ == 0 ? WOG : (w_ == 1 ? WOF : WOUT), 0, dscr, q_ / (DM / 32), q_ % (DM / 32), lane); } } } } while (0)
        for (int p = bx; p < NPAIR; p += G) {
            { const int half = tid >> 8, t = tid & 255, w4 = wave & 3;
              unsigned char* hb = lds + half * UB; float* Asm = (float*)hb; bf16_t* Ks = (bf16_t*)(hb + 16384); bf16_t* Vs = (bf16_t*)(hb + 32768); float* gcs = (float*)(hb + 49152); float* betas = gcs + 64; float* egs = gcs + 128;
              const int unit = 2 * p + half; const int bh = unit / NCH, n = unit % NCH, b = bh >> 4, h = bh & 15; const size_t R0 = (size_t)b * LP + 64 * n;
              if (w4 == 0) { float gv = GG[(size_t)bh * LP + 64 * n + lane]; const float be = BETA[(size_t)bh * LP + 64 * n + lane];
                  gv = wave_scan_incl(gv);
                  gcs[lane] = gv; betas[lane] = be; egs[lane] = __expf(gv); GC[(size_t)unit * 64 + lane] = gv; }
#pragma unroll
              for (int i = 0; i < 4; ++i) { const int ch = t + 256 * i, r = ch >> 4, c8 = (ch & 15) * 8;
                  *(u32x4*)(Ks + r * 128 + c8) = *(const u32x4*)(GKN + (R0 + r) * DM + h * 128 + c8);
                  *(u32x4*)(Vs + r * 128 + c8) = *(const u32x4*)(GVN + (R0 + r) * DM + h * 128 + c8); }
              const int qi = w4 >> 1, qj = w4 & 1, c = lane & 31, hi = lane >> 5;
              f32x16 mm = {}, qq = {};
              if (!(qi == 0 && qj == 1)) {
                  const bf16_t* ki = GKN + (R0 + 32 * qi + c) * DM + h * 128 + 8 * hi; const bf16_t* qi_ = GQN + (R0 + 32 * qi + c) * DM + h * 128 + 8 * hi;
                  const bf16_t* kj = GKN + (R0 + 32 * qj + c) * DM + h * 128 + 8 * hi;
#pragma unroll
                  for (int s = 0; s < 8; ++s) { const bf16x8 ak = *(const bf16x8*)(ki + 16 * s), aq = *(const bf16x8*)(qi_ + 16 * s), bk = *(const bf16x8*)(kj + 16 * s);
                      mm = MFMA32(ak, bk, mm); qq = MFMA32(aq, bk, qq); } }
              __syncthreads();
              bf16_t* qko = QKB + (size_t)unit * 4096; const int j = 32 * qj + c; const float gj = gcs[j];
#pragma unroll
              for (int r = 0; r < 16; ++r) { const int i = 32 * qi + fox::crow(r, hi); const float dec = __expf(gcs[i] - gj);
                  const float av = (i > j) ? betas[i] * mm[r] * dec : 0.f; const float qv = (i >= j) ? qq[r] * dec : 0.f;
                  Asm[i * 64 + j] = av; qko[i * 64 + j] = f2bf(qv); }
              __syncthreads(); }
            if (wave < 4) {
              const int u2 = wave >> 1, t = tid & 127;
              const unsigned char* hb = lds + u2 * UB; const float* Asm = (const float*)hb; const bf16_t* Ks = (const bf16_t*)(hb + 16384) + t; const bf16_t* Vs = (const bf16_t*)(hb + 32768) + t;
              const float* betas = (const float*)(hb + 49152) + 64; const float* egs = betas + 64;
              const int unit = 2 * p + u2;
              bf16_t* dv = WV + (size_t)unit * 8192 + t; bf16_t* dk = WK + (size_t)unit * 8192 + t;
              f32x2 w[64]; unsigned kpk[4]; bf16_t* kto = KT + (size_t)unit * 8192 + t * 64;
#pragma clang loop unroll(full)
              for (int i = 0; i < 64; ++i) {
                  const bf16_t kraw = Ks[i * 128]; const float be = betas[i];
                  f32x2 acc; acc.x = bf2f(Vs[i * 128]) * be; acc.y = bf2f(kraw) * be * egs[i];
                  if (i & 1) kpk[(i >> 1) & 3] |= (unsigned)kraw << 16; else kpk[(i >> 1) & 3] = kraw;
                  if ((i & 7) == 7) { u32x4 o; o.x = kpk[0]; o.y = kpk[1]; o.z = kpk[2]; o.w = kpk[3]; *(u32x4*)(kto + (i & ~7)) = o; }
                  const int arow = __float_as_int(Asm[i * 64 + lane]);
#pragma clang loop unroll(full)
                  for (int j0 = 0; j0 < 64; j0 += 8) {
                      if (j0 < i) {
                      float sc[8];
#pragma clang loop unroll(full)
                      for (int jj = 0; jj < 8; ++jj) sc[jj] = (j0 + jj < i) ? -__int_as_float(__builtin_amdgcn_readlane(arow, j0 + jj)) : 0.f;
#pragma clang loop unroll(full)
                      for (int jj = 0; jj < 8; ++jj) if (j0 + jj < i) { f32x2 s2; s2.x = sc[jj]; s2.y = sc[jj]; acc = __builtin_elementwise_fma(s2, w[j0 + jj], acc); }
                      }
                  }
                  w[i] = acc;
                  dv[i * 128] = f2bf(acc.x); dk[i * 128] = f2bf(acc.y); }
            } else { DEFER_ITEMS(7); }
            __syncthreads();
        }
        if (wave >= 4) { DEFER_ITEMS(1 << 30); }
#undef DEFER_ITEMS
    }
    xcd_barrier(xbar);

    {
        PH_BEGIN
        unsigned* ctl = WSP(unsigned, O_CTL);
        bf16_t* GQN = WSP(bf16_t, O_GQN); bf16_t* WV = WSP(bf16_t, O_WV); bf16_t* WK = WSP(bf16_t, O_WK); bf16_t* KT = WSP(bf16_t, O_KT); bf16_t* QKB = WSP(bf16_t, O_QK); float* GC = WSP(float, O_GC);
        bf16_t* Z = WSP(bf16_t, O_Z); bf16_t* YA = WSP(bf16_t, O_YA); bf16_t* YB = WSP(bf16_t, O_YB); bf16_t* FQN = WSP(bf16_t, O_FQN); bf16_t* FKN = WSP(bf16_t, O_FKN); bf16_t* FVN = WSP(bf16_t, O_FVN); float* FB = WSP(float, O_FB);
        if (bx < 2 * NB * NH) {
            const int bh = (bx & 7) + 8 * (bx >> 4), half = (bx >> 3) & 1, b = bh >> 4, h = bh & 15, m16 = lane & 15, g4 = lane >> 4;
            constexpr int GBUF = 65792, G_WK = 0, G_Q = 16384, G_QK = 32768, G_KT = 40960, G_WV = 57344, G_GC = 65536;
            const unsigned lds0 = (unsigned)(uintptr_t)ldsl;
#define CROW(t_, i_) (32 * ((t_) >> 1) + 8 * ((i_) >> 2) + 4 * ((t_) & 1) + ((i_) & 3))
#define KEY256(row_) (((((row_) >> 3) & 3) << 2) | ((row_) & 3))
#define KEY128(row_) (((((row_) >> 3) & 3) << 1) | (((row_) >> 1) & 1))
            if (wave >= 4) {
                const int tl = tid - 256, lw = wave - 4;
                for (int n = 0; n < NCH; ++n) {
                    const int un_ = bh * NCH + n; const unsigned db_ = (unsigned)__builtin_amdgcn_readfirstlane((int)(lds0 + (n & 1) * GBUF + lw * 1024));
#pragma unroll
                    for (int r_ = 0; r_ < 4; ++r_) { const int P_ = r_ * 256 + tl;
                        { const int row_ = P_ >> 4, ch_ = (P_ & 15) ^ KEY256(row_);
                          glds16(WK + (size_t)un_ * 8192 + row_ * 128 + ch_ * 8, db_ + G_WK + r_ * 4096);
                          glds16(GQN + ((size_t)b * LP + 64 * n + row_) * DM + h * 128 + ch_ * 8, db_ + G_Q + r_ * 4096); }
                        { const int row_ = P_ >> 3, ch_ = (P_ & 7) ^ KEY128(row_);
                          glds16(KT + (size_t)un_ * 8192 + row_ * 64 + ch_ * 8, db_ + G_KT + r_ * 4096); } }
#pragma unroll
                    for (int r_ = 0; r_ < 2; ++r_) { const int P_ = r_ * 256 + tl, row_ = P_ >> 3, cs_ = P_ & 7;
                        glds16(QKB + (size_t)un_ * 4096 + row_ * 64 + (cs_ ^ KEY128(row_)) * 8, db_ + G_QK + r_ * 4096);
                        glds16(WV + (size_t)un_ * 8192 + row_ * 128 + half * 64 + cs_ * 8, db_ + G_WV + r_ * 4096); }
                    if (tl < 16) glds16(GC + (size_t)un_ * 64 + tl * 4, db_ + G_GC);
                    asm volatile("s_waitcnt vmcnt(0)" ::: "memory"); __builtin_amdgcn_s_barrier();
                }
                __builtin_amdgcn_s_barrier();
            } else {
                const int vl = 16 * wave;
#define FR256(tile_, ct_, ks_) (*(const LAS bf16x8*)((tile_) + CROW(ct_, m16) * 256 + (((4 * (ks_) + g4) ^ m16) << 4)))
#define FR128(tile_, t_, s2_) (*(const LAS bf16x8*)((tile_) + CROW(t_, m16) * 128 + (((4 * (s2_) + g4) ^ (((m16 >> 2) << 1) | ((m16 >> 1) & 1))) << 4)))
                f32x4 Sacc[8];
#pragma unroll
                for (int i = 0; i < 8; ++i) Sacc[i] = (f32x4){0.f, 0.f, 0.f, 0.f};
                constexpr float L2E = 1.4426950408889634f;
                __builtin_amdgcn_s_barrier();
                for (int n = 0; n < NCH; ++n) {
                    const LAS unsigned char* tb = ldsl + (n & 1) * GBUF;
                    const LAS float* gcl = (const LAS float*)(tb + G_GC); const LAS bf16_t* wvl = (const LAS bf16_t*)(tb + G_WV) + vl + m16;
                    bf16x8 Sb[4];
#pragma unroll
                    for (int ks = 0; ks < 4; ++ks) Sb[ks] = packacc(Sacc[2 * ks], Sacc[2 * ks + 1]);
                    f32x4 Uu[4], O1[4], gcv[4];
#pragma unroll
                    for (int ct = 0; ct < 4; ++ct) { Uu[ct] = (f32x4){0.f, 0.f, 0.f, 0.f}; O1[ct] = Uu[ct]; gcv[ct] = *(const LAS f32x4*)(gcl + CROW(ct, 4 * g4)) * L2E; }
                    const float gl = gcl[63] * L2E;
#pragma unroll
                    for (int ct = 0; ct < 4; ++ct) {
#pragma unroll
                        for (int ks = 0; ks < 4; ++ks) { Uu[ct] = MFMA16(FR256(tb + G_WK, ct, ks), Sb[ks], Uu[ct]); O1[ct] = MFMA16(FR256(tb + G_Q, ct, ks), Sb[ks], O1[ct]); }
                        __builtin_amdgcn_sched_barrier(0); }
                    f32x4 vn[4], vs[4];
#pragma unroll
                    for (int ct = 0; ct < 4; ++ct)
#pragma unroll
                        for (int r = 0; r < 4; ++r) { vn[ct][r] = bf2f(wvl[CROW(ct, 4 * g4 + r) * 64]) - Uu[ct][r];
                            O1[ct][r] *= __builtin_amdgcn_exp2f(gcv[ct][r]); vs[ct][r] = vn[ct][r] * __builtin_amdgcn_exp2f(gl - gcv[ct][r]); }
                    bf16x8 vnb[2], vsb[2];
#pragma unroll
                    for (int s2 = 0; s2 < 2; ++s2) { vnb[s2] = packacc(vn[2 * s2], vn[2 * s2 + 1]); vsb[s2] = packacc(vs[2 * s2], vs[2 * s2 + 1]); }
#pragma unroll
                    for (int ct = 0; ct < 4; ++ct) {
#pragma unroll
                        for (int s2 = 0; s2 < 2; ++s2) O1[ct] = MFMA16(FR128(tb + G_QK, ct, s2), vnb[s2], O1[ct]);
                        if (ct & 1) __builtin_amdgcn_sched_barrier(0); }
                    const float glast = __builtin_amdgcn_exp2f(gl);
#pragma unroll
                    for (int mt = 0; mt < 8; ++mt) { Sacc[mt] *= glast;
#pragma unroll
                        for (int s2 = 0; s2 < 2; ++s2) Sacc[mt] = MFMA16(FR128(tb + G_KT, mt, s2), vsb[s2], Sacc[mt]);
                        if ((mt & 3) == 3) __builtin_amdgcn_sched_barrier(0); }
                    if (n >= 1) {
                        bf16_t* op = YA + ((size_t)b * SEQ + 64 * (n - 1)) * DM + h * 128 + 64 * half + vl + m16;
#pragma unroll
                        for (int ct = 0; ct < 4; ++ct)
#pragma unroll
                            for (int r = 0; r < 4; ++r) op[(unsigned)(CROW(ct, 4 * g4 + r) * DM)] = f2bf(O1[ct][r]);
                    }
                    __builtin_amdgcn_s_barrier();
                }
#undef FR256
#undef FR128
            }
#undef CROW
#undef KEY256
#undef KEY128
            asm volatile("s_waitcnt vmcnt(0) lgkmcnt(0)" ::: "memory");
            __syncthreads();
            if (tid == 0) { __builtin_amdgcn_fence(__ATOMIC_RELEASE, "agent"); asm volatile("s_waitcnt vmcnt(0)" ::: "memory"); (void)xb_add(ctl + CW_SCAN, 1u); }
        }
        {
            volatile int* misc = (volatile int*)(lds + MISC_OFF);
            auto mkref = [&](int L) { const int v_ = L & 63, qb = 15 - (v_ >> 2), bh = (L >> 6) + 8 * (v_ & 3), b = bh >> 4, h = bh & 15; fox::BlockRef r;
                r.Q = FQN + ((size_t)b * LP + XOFF + qb * 256) * DM + h * 128; r.K = FKN + (size_t)b * LP * DM + h * 128; r.V = FVN + (size_t)b * LP * DM + h * 128;
                r.O = YB + ((size_t)b * SEQ + qb * 256) * DM + h * 128; r.bias = FB + (size_t)bh * LP; r.P0 = XOFF + qb * 256; return r; };
            const int xcd = (int)(__builtin_amdgcn_s_getreg((3 << 11) | 20) & 7u);
#define FOX_TAKE(slot_) do { if (tid == 0) { int code_ = -1; for (int q_ = 0; q_ < 8; ++q_) { const int x_ = (xcd + q_) & 7; const int v_ = (int)atomicAdd(ctl + CW_QUEUE + 64 * x_, 1u); if (v_ < 64) { code_ = x_ * 64 + v_; break; } } misc[slot_] = code_; } } while (0)
            FOX_TAKE(0);
            __syncthreads();
            int L = __builtin_amdgcn_readfirstlane(misc[0]);
            if (L >= 0) {
                fox::BlockRef cur = mkref(L); fox::Seam S; int par = 0;
                fox::causal_prime(cur, (char*)lds, S, par);
                for (;;) {
                    FOX_TAKE(1);
                    __syncthreads();
                    const int Ln = __builtin_amdgcn_readfirstlane(misc[1]); const bool last = Ln < 0;
                    const fox::BlockRef nxt = last ? cur : mkref(Ln);
                    fox::causal_block(cur, nxt, (char*)lds, S, par);
                    if (last) break;
                    cur = nxt; par ^= 1;
                }
            }
#undef FOX_TAKE
        }
        {
            { unsigned sp_ = 0; while ((unsigned)__builtin_amdgcn_readfirstlane((int)xb_ld(ctl + CW_SCAN)) < 64u) { __builtin_amdgcn_s_sleep(4); if (++sp_ > (1u << 22)) break; } }
            __builtin_amdgcn_fence(__ATOMIC_ACQUIRE, "agent");
        const int sub = lane >> 4, l16 = lane & 15;
        const f32x4 g0 = *(const f32x4*)(ap->gdn_g + l16 * 8), g1 = *(const f32x4*)(ap->gdn_g + l16 * 8 + 4);
        for (int it0 = gw; it0 < MX * NH / 4; it0 += 4 * NGW) {
            u32x4 ou[4], zu[4];
#pragma unroll
            for (int k = 0; k < 4; ++k) { const int it = it0 + k * NGW; const size_t off = (size_t)(it * 4 + sub) * 128 + l16 * 8;
                if (it < MX * NH / 4) { ou[k] = *(const u32x4*)(YA + off); zu[k] = *(const u32x4*)(Z + off); } else { ou[k] = (u32x4){0u, 0u, 0u, 0u}; zu[k] = ou[k]; } }
#pragma unroll
            for (int k = 0; k < 4; ++k) { const int it = it0 + k * NGW; const size_t off = (size_t)(it * 4 + sub) * 128 + l16 * 8;
                float o[8], z[8];
                o[0] = __uint_as_float(ou[k].x << 16); o[1] = __uint_as_float(ou[k].x & 0xffff0000u); o[2] = __uint_as_float(ou[k].y << 16); o[3] = __uint_as_float(ou[k].y & 0xffff0000u);
                o[4] = __uint_as_float(ou[k].z << 16); o[5] = __uint_as_float(ou[k].z & 0xffff0000u); o[6] = __uint_as_float(ou[k].w << 16); o[7] = __uint_as_float(ou[k].w & 0xffff0000u);
                z[0] = __uint_as_float(zu[k].x << 16); z[1] = __uint_as_float(zu[k].x & 0xffff0000u); z[2] = __uint_as_float(zu[k].y << 16); z[3] = __uint_as_float(zu[k].y & 0xffff0000u);
                z[4] = __uint_as_float(zu[k].z << 16); z[5] = __uint_as_float(zu[k].z & 0xffff0000u); z[6] = __uint_as_float(zu[k].w << 16); z[7] = __uint_as_float(zu[k].w & 0xffff0000u);
                float ss = 0.f;
#pragma unroll
                for (int e = 0; e < 8; ++e) ss += o[e] * o[e];
                ss = sum16(ss);
                const float rstd = rsqrtf(ss * (1.f / DH) + EPS);
                float y[8];
#pragma unroll
                for (int e = 0; e < 8; ++e) y[e] = o[e] * rstd * (e < 4 ? g0[e] : g1[e - 4]) * (z[e] * __builtin_amdgcn_rcpf(1.f + __expf(-z[e])));
                u32x4 w; w.x = cvt_pk_bf16(y[0], y[1]); w.y = cvt_pk_bf16(y[2], y[3]); w.z = cvt_pk_bf16(y[4], y[5]); w.w = cvt_pk_bf16(y[6], y[7]);
                if (it < MX * NH / 4) *(u32x4*)(YA + off) = w; }
        }
        }
    }
    xcd_barrier(xbar);

    {
        PH_BEGIN
        bf16_t* YA = WSP(bf16_t, O_YA); bf16_t* WOG = WSP(bf16_t, O_WOG); bf16_t* GA = WSP(bf16_t, O_GA); bf16_t* GB = WSP(bf16_t, O_GB); bf16_t* MIX = WSP(bf16_t, O_MIX);
        pg8::Gemm g{YA, WOG, MX, 2 * DM, DM, 8, (size_t)(O_YB - O_YA)}; pg8::PairOrder S{MX / 256, DM / 256, G, bx};
        pg8::EpiMix E{GA, GB, MIX};
        pg8::gemm_phase<pg8::EpiMix, pg8::PairOrder>(ldsl, g, S, E);
    }
    xcd_barrier(xbar);
    {
        PH_BEGIN
        bf16_t* MIX = WSP(bf16_t, O_MIX); bf16_t* WOUT = WSP(bf16_t, O_WOUT); bf16_t* A2 = WSP(bf16_t, O_A2); float* SS1 = (float*)(WSP(unsigned, O_CTL) + CW_SS1);
        pg8::Gemm g{MIX, WOUT, MX, DM, DM, 1 << 30, 0}; pg8::StaticOrder S; S.init(MX, DM, G, bx);
        pg8::EpiRes E{ap->x, ap->out, A2, ap->mlp_g, SS1};
        pg8::gemm_phase<pg8::EpiRes, pg8::StaticOrder>(ldsl, g, S, E);
    }
    xcd_barrier(xbar);
    {
        PH_BEGIN
        bf16_t* A2 = WSP(bf16_t, O_A2); bf16_t* WUP = WSP(bf16_t, O_WUP); bf16_t* HID = WSP(bf16_t, O_HID); float* SS1 = (float*)(WSP(unsigned, O_CTL) + CW_SS1);
        pg8::Gemm g{A2, WUP, MX, DFF, DM, 1 << 30, 0}; pg8::StaticOrder S; S.init(MX, DFF, G, bx);
        pg8::EpiUp E{SS1, HID};
        pg8::gemm_phase<pg8::EpiUp, pg8::StaticOrder>(ldsl, g, S, E);
    }
    xcd_barrier(xbar);
    {
        PH_BEGIN
        bf16_t* HID = WSP(bf16_t, O_HID); bf16_t* WDN = WSP(bf16_t, O_WDN); float* SS2 = (float*)(WSP(unsigned, O_CTL) + CW_SS2);
        pg8::Gemm g{HID, WDN, MX, DM, DFF, 1 << 30, 0}; pg8::StaticOrder S; S.init(MX, DM, G, bx);
        if (G == 256) { pg8::EpiFinal E{ap->out, ap->out, ap->final_g, SS2, WSP(unsigned, O_CTL) + CW_PANEL};
            pg8::gemm_phase<pg8::EpiFinal, pg8::StaticOrder>(ldsl, g, S, E); }
        else { pg8::EpiRes E{ap->out, ap->out, nullptr, nullptr, SS2};
            pg8::gemm_phase<pg8::EpiRes, pg8::StaticOrder>(ldsl, g, S, E); }
    }
    if (gridDim.x != 256) {
    xcd_barrier(xbar);
    {
        PH_BEGIN
        float* SS2 = (float*)(WSP(unsigned, O_CTL) + CW_SS2);
        for (int m = gw; m < MX; m += NGW) {
            const float rstd = rsqrtf(SS2[m] * (1.f / DM) + EPS);
            f32x4* o = (f32x4*)(ap->out + (size_t)m * DM) + lane; const f32x4* gr = (const f32x4*)ap->final_g + lane;
#pragma unroll
            for (int j = 0; j < 8; ++j) { f32x4 v = o[64 * j]; const f32x4 gg = gr[64 * j]; v = v * rstd; v[0] *= gg[0]; v[1] *= gg[1]; v[2] *= gg[2]; v[3] *= gg[3]; o[64 * j] = v; }
        }
    }
    }
}

extern "C" void kernel_launch(void* const* d_in, const int* in_sizes, int n_in, void* d_out, int out_size, void* d_ws, size_t ws_size, hipStream_t stream) {
    static int grid = 0;
    if (grid == 0) {
        if (n_in != 18 || in_sizes[0] != MX * DM || out_size != MX * DM || ws_size < WS_END) { fprintf(stderr, "kernel_launch: unexpected shapes (n_in %d, in0 %d, out %d, ws %zu < %zu)\n", n_in, n_in > 0 ? in_sizes[0] : -1, out_size, ws_size, (size_t)WS_END); grid = -1; return; }
        int dev = 0, cus = 0, per_cu = 0;
        (void)hipGetDevice(&dev); (void)hipDeviceGetAttribute(&cus, hipDeviceAttributeMultiprocessorCount, dev);
        if (hipFuncSetAttribute((const void*)mk_fwd, hipFuncAttributeMaxDynamicSharedMemorySize, LDS_BYTES) != hipSuccess) { fprintf(stderr, "kernel_launch: hipFuncSetAttribute failed\n"); grid = -1; return; }
        if (hipOccupancyMaxActiveBlocksPerMultiprocessor(&per_cu, (const void*)mk_fwd, 512, LDS_BYTES) != hipSuccess || per_cu < 1) { fprintf(stderr, "kernel_launch: occupancy query says %d\n", per_cu); per_cu = 1; }
        (void)hipGetLastError();
        grid = cus > 0 ? cus : 256;
    }
    if (grid < 0) return;
    (void)hipMemsetAsync((char*)d_ws + O_CTL, 0, CTL_BYTES, stream);
    Args a{};
    const float** p = (const float**)&a;
    for (int i = 0; i < 18; ++i) p[i] = (const float*)d_in[i];
    a.out = (float*)d_out; a.ws = (unsigned char*)d_ws;
    void* kargs[] = {&a};
    hipError_t e = hipLaunchCooperativeKernel((const void*)mk_fwd, dim3(grid), dim3(512), kargs, LDS_BYTES, stream);
    if (e != hipSuccess) fprintf(stderr, "kernel_launch: cooperative launch failed: %s (grid %d)\n", hipGetErrorString(e), grid);
}
```
